# Optimizing an MI355X kernel written in HIP

```python
import numpy as np
import jax
import jax.numpy as jnp
from jax import lax

D_MODEL = 2048
BATCH = 8
SEQ = 2048
DEPTH = 2

HEAD_DIM = D_MODEL // 16
H_MLSTM = 4
H_NA = 8
H_RET = 4
W_MLSTM = H_MLSTM * HEAD_DIM
W_NA = H_NA * HEAD_DIM
W_RET = H_RET * HEAD_DIM
D_MIX = W_MLSTM + W_NA + W_RET
IN_SIZES = (W_MLSTM, W_MLSTM, W_MLSTM, W_MLSTM, 4 * H_MLSTM, W_NA, W_NA, W_NA, W_RET, W_RET, W_RET, W_RET)
IN_COLS = sum(IN_SIZES)
D_FF = 11 * D_MODEL // 4
CONV_K = 3
CHUNK = 128
GRID_W = 64
WIN_R = 8
WIN_C = 16
QB_C = 16
KB_C = 32
ROPE_BASE = 10000.0
EPS = 1e-6
NEG = -1e30

kernel_name = 'hybrid_mlstm_natten_retention_macaron'


def rms_norm(x, g):
    xf = x.astype(jnp.float32)
    y = xf * lax.rsqrt(jnp.mean(xf * xf, axis=-1, keepdims=True) + EPS)
    return (y * g.astype(jnp.float32)).astype(x.dtype)


def head_norm(h, g, n_heads):
    B, T, _ = h.shape
    hh = h.reshape(B, T, n_heads, -1)
    hh = hh * lax.rsqrt(jnp.mean(hh * hh, axis=-1, keepdims=True) + EPS)
    return hh.reshape(B, T, -1) * g.astype(jnp.float32)


def swiglu(x, w_gu, w_down):
    gate, up = jnp.split(x @ w_gu, 2, axis=-1)
    return (jax.nn.silu(gate) * up) @ w_down


def to_heads(t, n_heads):
    B, T, _ = t.shape
    return t.reshape(B, T, n_heads, -1).transpose(0, 2, 1, 3)


def from_heads(t):
    B, H, T, d = t.shape
    return t.transpose(0, 2, 1, 3).reshape(B, T, H * d)


def to_chunks(t):
    B, H, T = t.shape[:3]
    return jnp.moveaxis(t.reshape(B, H, T // CHUNK, CHUNK, *t.shape[3:]), 2, 0)


def from_chunks(t):
    t = jnp.moveaxis(t, 0, 2)
    B, H, NC, L = t.shape[:4]
    return t.reshape(B, H, NC * L, *t.shape[4:])


def flip_t(t):
    return jnp.flip(t, axis=2)


def rope(x):
    T, d = x.shape[2], x.shape[3]
    inv = ROPE_BASE ** (-jnp.arange(0, d, 2, dtype=jnp.float32) / d)
    ang = jnp.arange(T, dtype=jnp.float32)[:, None] * inv[None, :]
    cos, sin = jnp.cos(ang), jnp.sin(ang)
    x1, x2 = jnp.split(x, 2, axis=-1)
    return jnp.concatenate([x1 * cos - x2 * sin, x1 * sin + x2 * cos], axis=-1)


def depthwise_conv(x, w, b):
    C = x.shape[-1]
    y = lax.conv_general_dilated(x, w.reshape(CONV_K, 1, C).astype(x.dtype), window_strides=(1,),
                                 padding=[(CONV_K // 2, CONV_K // 2)],
                                 dimension_numbers=('NWC', 'WIO', 'NWC'), feature_group_count=C)
    return y + b.astype(x.dtype)


def mlstm_chunk_scan(q, k, v, log_i, log_f):
    B, H, T, d = q.shape
    tri = jnp.tril(jnp.ones((CHUNK, CHUNK), dtype=bool))
    b_cum = jnp.cumsum(to_chunks(log_f), axis=-1)
    li = to_chunks(log_i)

    def step(carry, xs):
        C, n, m = carry
        qc, kc, vc, lic, bc = xs
        g = bc[..., -1]
        dmat = jnp.where(tri, bc[..., :, None] - bc[..., None, :] + lic[..., None, :], NEG)
        inter = bc + m[..., None]
        m_t = jnp.maximum(inter, jnp.max(dmat, axis=-1))
        s = jnp.einsum('bhtd,bhsd->bhts', qc, kc) * jnp.exp(dmat - m_t[..., None])
        w_inter = jnp.exp(inter - m_t)
        num = jnp.einsum('bhts,bhsd->bhtd', s, vc) + w_inter[..., None] * jnp.einsum('bhtd,bhde->bhte', qc, C)
        den = jnp.sum(s, axis=-1) + w_inter * jnp.einsum('bhtd,bhd->bht', qc, n)
        h = num / jnp.maximum(jnp.abs(den), jnp.exp(-m_t))[..., None]
        a = g[..., None] - bc + lic
        m_new = jnp.maximum(g + m, jnp.max(a, axis=-1))
        wk = jnp.exp(a - m_new[..., None])
        decay = jnp.exp(g + m - m_new)
        C = decay[..., None, None] * C + jnp.einsum('bhs,bhsd,bhse->bhde', wk, kc, vc)
        n = decay[..., None] * n + jnp.einsum('bhs,bhsd->bhd', wk, kc)
        return (C, n, m_new), h

    init = (jnp.zeros((B, H, d, d), jnp.float32), jnp.zeros((B, H, d), jnp.float32),
            jnp.full((B, H), NEG, jnp.float32))
    _, h = lax.scan(step, init, (to_chunks(q), to_chunks(k), to_chunks(v), li, b_cum))
    return from_chunks(h)


def retention_chunk_scan(q, k, v, log_gamma):
    B, H, T, d = q.shape
    pos = jnp.arange(CHUNK, dtype=jnp.float32)
    diff = pos[:, None] - pos[None, :]
    lower = diff >= 0
    intra = jnp.where(lower, jnp.exp(jnp.where(lower, diff, 0.0) * log_gamma[:, None, None]), 0.0)
    xi = jnp.exp((pos + 1.0) * log_gamma[:, None])
    zeta = jnp.exp((CHUNK - 1.0 - pos) * log_gamma[:, None])
    g_chunk = jnp.exp(CHUNK * log_gamma)

    def step(R, xs):
        qc, kc, vc = xs
        s = jnp.einsum('bhtd,bhsd->bhts', qc, kc) * intra
        o = jnp.einsum('bhts,bhsd->bhtd', s, vc) + xi[..., None] * jnp.einsum('bhtd,bhde->bhte', qc, R)
        R = g_chunk[:, None, None] * R + jnp.einsum('bhsd,bhse->bhde', kc * zeta[..., None], vc)
        return R, o

    _, o = lax.scan(step, jnp.zeros((B, H, d, d), jnp.float32), (to_chunks(q), to_chunks(k), to_chunks(v)))
    return from_chunks(o)


def neighborhood_attention(q, k, v, rpb, rows):
    B, H, T, d = q.shape
    wr = min(WIN_R, rows)
    n_cb = GRID_W // QB_C
    q_cols = np.arange(GRID_W).reshape(n_cb, QB_C)
    win_c0 = np.clip(q_cols - WIN_C // 2, 0, GRID_W - WIN_C)
    key_cols = np.clip(win_c0[:, 0], 0, GRID_W - KB_C)[:, None] + np.arange(KB_C)[None, :]
    kc = key_cols[:, None, :]
    col_ok = (kc >= win_c0[:, :, None]) & (kc < win_c0[:, :, None] + WIN_C)
    dc_idx = np.clip(kc - q_cols[:, :, None] + WIN_C - 1, 0, 2 * WIN_C - 2)
    col_bias = rpb.astype(jnp.float32)[:, :, dc_idx]
    col_mask = jnp.where(jnp.asarray(col_ok), 0.0, NEG).astype(jnp.float32)
    q5 = (q * d ** -0.5).reshape(B, H, rows, GRID_W, d)
    k5 = k.reshape(B, H, rows, GRID_W, d)
    v5 = v.reshape(B, H, rows, GRID_W, d)

    def row_block(r):
        r0 = jnp.clip(r - wr // 2, 0, rows - wr)
        k_blk = lax.dynamic_slice_in_dim(k5, r0, wr, axis=2)[:, :, :, key_cols]
        v_blk = lax.dynamic_slice_in_dim(v5, r0, wr, axis=2)[:, :, :, key_cols]
        q_blk = lax.dynamic_index_in_dim(q5, r, axis=2, keepdims=False).reshape(B, H, n_cb, QB_C, d)
        s = jnp.einsum('bhnqd,bhrnkd->bhnqrk', q_blk, k_blk).astype(jnp.float32)
        dr_idx = r0 + jnp.arange(wr) - r + WIN_R - 1
        bias = jnp.take(col_bias, dr_idx, axis=1).transpose(0, 2, 3, 1, 4)
        s = s + bias[None] + col_mask[None, None, :, :, None, :]
        p = jax.nn.softmax(s.reshape(B, H, n_cb, QB_C, wr * KB_C), axis=-1).reshape(s.shape)
        o = jnp.einsum('bhnqrk,bhrnkd->bhnqd', p.astype(v.dtype), v_blk)
        return o.reshape(B, H, GRID_W, d)

    out = lax.map(row_block, jnp.arange(rows))
    return jnp.moveaxis(out, 0, 2).reshape(B, H, T, d)


def token_mix(u, w_in, conv_w, conv_b, gate_b, m_gain, rpb, decay_logit, r_gain, w_out, rows):
    f32 = jnp.float32
    B, T, _ = u.shape
    proj = u @ w_in
    mq, mk, mv, mo, mg, nq, nk, nv, rq, rk, rv, rg = jnp.split(proj, np.cumsum(IN_SIZES)[:-1].tolist(), axis=-1)

    mqk = jax.nn.silu(depthwise_conv(jnp.concatenate([mq, mk], axis=-1), conv_w, conv_b))
    mq, mk = jnp.split(mqk, 2, axis=-1)
    q = to_heads(mq, H_MLSTM).astype(f32) * HEAD_DIM ** -0.5
    k = to_heads(mk, H_MLSTM).astype(f32)
    v = to_heads(mv, H_MLSTM).astype(f32)
    g = (mg.astype(f32) + gate_b.astype(f32).reshape(-1)).reshape(B, T, 4, H_MLSTM).transpose(2, 0, 3, 1)
    h_f = mlstm_chunk_scan(q, k, v, g[0], jax.nn.log_sigmoid(g[1]))
    h_b = flip_t(mlstm_chunk_scan(flip_t(q), flip_t(k), flip_t(v), flip_t(g[2]), flip_t(jax.nn.log_sigmoid(g[3]))))
    m_out = head_norm(jax.nn.sigmoid(mo.astype(f32)) * from_heads(h_f + h_b), m_gain, H_MLSTM)

    n_out = from_heads(neighborhood_attention(to_heads(nq, H_NA), to_heads(nk, H_NA), to_heads(nv, H_NA), rpb, rows))

    q = rope(to_heads(rq, H_RET).astype(f32))
    k = rope(to_heads(rk, H_RET).astype(f32)) * HEAD_DIM ** -0.5
    v = to_heads(rv, H_RET).astype(f32)
    lg = jax.nn.log_sigmoid(decay_logit.astype(f32))
    r = retention_chunk_scan(q, k, v, lg[0]) + flip_t(retention_chunk_scan(flip_t(q), flip_t(k), flip_t(v), lg[1]))
    r_out = jax.nn.silu(rg.astype(f32)) * head_norm(from_heads(r), r_gain, H_RET)

    mixed = jnp.concatenate([m_out.astype(u.dtype), n_out.astype(u.dtype), r_out.astype(u.dtype)], axis=-1)
    return mixed @ w_out


def setup_inputs(seed: int = 0) -> dict:
    key = jax.random.key(seed)
    ks = jax.random.split(key, 20)
    f32 = jnp.float32

    def normal(k, shape, scale):
        return jax.random.normal(k, shape, f32) * scale

    def gain(k, shape):
        return 1.0 + normal(k, shape, 0.02)

    gamma0 = 1.0 - 2.0 ** (-5.0 - np.arange(H_RET))
    logit0 = jnp.asarray(np.log(gamma0 / (1.0 - gamma0)), f32)
    f_bias = jnp.linspace(3.0, 6.0, H_MLSTM, dtype=f32)
    zeros_h = jnp.zeros((H_MLSTM,), f32)
    gate_off = jnp.stack([zeros_h, f_bias, zeros_h, f_bias])
    return {
        'x': normal(ks[0], (BATCH, SEQ, D_MODEL), 1.0),
        'ffn1_norm': gain(ks[1], (DEPTH, D_MODEL)),
        'ffn1_w_gu': normal(ks[2], (DEPTH, D_MODEL, 2 * D_FF), D_MODEL ** -0.5),
        'ffn1_w_down': normal(ks[3], (DEPTH, D_FF, D_MODEL), D_FF ** -0.5),
        'mix_norm': gain(ks[4], (DEPTH, D_MODEL)),
        'w_in': normal(ks[5], (DEPTH, D_MODEL, IN_COLS), D_MODEL ** -0.5),
        'mlstm_conv_w': normal(ks[6], (DEPTH, CONV_K, 2 * W_MLSTM), CONV_K ** -0.5),
        'mlstm_conv_b': normal(ks[7], (DEPTH, 2 * W_MLSTM), 0.02),
        'mlstm_gate_b': gate_off + normal(ks[8], (DEPTH, 4, H_MLSTM), 0.1),
        'mlstm_head_norm': gain(ks[9], (DEPTH, W_MLSTM)),
        'na_rpb': normal(ks[10], (DEPTH, H_NA, 2 * WIN_R - 1, 2 * WIN_C - 1), 0.1),
        'ret_decay_logit': logit0 + normal(ks[11], (DEPTH, 2, H_RET), 0.01),
        'ret_head_norm': gain(ks[12], (DEPTH, W_RET)),
        'w_out': normal(ks[13], (DEPTH, D_MIX, D_MODEL), D_MIX ** -0.5),
        'ffn2_norm': gain(ks[14], (DEPTH, D_MODEL)),
        'ffn2_w_gu': normal(ks[15], (DEPTH, D_MODEL, 2 * D_FF), D_MODEL ** -0.5),
        'ffn2_w_down': normal(ks[16], (DEPTH, D_FF, D_MODEL), D_FF ** -0.5),
        'final_norm': gain(ks[17], (D_MODEL,)),
    }


def reference(x, ffn1_norm, ffn1_w_gu, ffn1_w_down, mix_norm, w_in, mlstm_conv_w, mlstm_conv_b, mlstm_gate_b,
              mlstm_head_norm, na_rpb, ret_decay_logit, ret_head_norm, w_out, ffn2_norm, ffn2_w_gu, ffn2_w_down,
              final_norm):
    rows = x.shape[1] // GRID_W
    h = x
    for l in range(DEPTH):
        h = h + 0.5 * swiglu(rms_norm(h, ffn1_norm[l]), ffn1_w_gu[l], ffn1_w_down[l])
        h = h + token_mix(rms_norm(h, mix_norm[l]), w_in[l], mlstm_conv_w[l], mlstm_conv_b[l], mlstm_gate_b[l],
                          mlstm_head_norm[l], na_rpb[l], ret_decay_logit[l], ret_head_norm[l], w_out[l], rows)
        h = h + 0.5 * swiglu(rms_norm(h, ffn2_norm[l]), ffn2_w_gu[l], ffn2_w_down[l])
    return rms_norm(h, final_norm)
```

```cpp
#include <hip/hip_runtime.h>
#include <hip/hip_cooperative_groups.h>
#include <cstdio>
#include <cstdint>
namespace cg = cooperative_groups;
__device__ __forceinline__ int tid_fresh(int wv) { int t; asm volatile("v_mbcnt_lo_u32_b32 %0, -1, 0\n\tv_mbcnt_hi_u32_b32 %0, -1, %0" : "=v"(t)); return wv * 64 + t; }
namespace pg8 {
#define PG8_LAS __attribute__((address_space(3)))
typedef unsigned short bf16_t;
typedef short bf16x8 __attribute__((ext_vector_type(8)));
typedef float f32x4 __attribute__((ext_vector_type(4)));
typedef unsigned u32x4 __attribute__((ext_vector_type(4)));
constexpr int BM = 256, BK = 64, HALF = 128, HTB = HALF * BK * 2  , STAGE_BYTES = 8 * HTB, NXCD = 8, WGM = 8;

__host__ __device__ __forceinline__ int lds_byte(int r, int c) { const int st = (r >> 4) * 2 + (c >> 5), rr = r & 15, cc = c & 31, ob = rr * 64 + cc * 2; return st * 1024 + (ob ^ (((ob >> 9) & 1) << 5)); }
__host__ __device__ __forceinline__ void stage_rc(int b, int& R, int& C) { const int st = b / 1024, sb = b % 1024, swz = sb ^ (((sb >> 9) & 1) << 5); R = (st >> 1) * 16 + swz / 64; C = (st & 1) * 32 + (swz % 64) / 2; }
__host__ __device__ __forceinline__ int perm32(int rho) { const int n = rho >> 4, i = rho & 15; return 8 * (i >> 2) + 4 * n + (i & 3); }

struct Unit { int pm, pn; };
struct Gemm { const bf16_t* A; const bf16_t* Bt; int M, N, K; };

struct StaticOrder {
    int nM, nN, nwg, G, c, wgm, flip;
    __host__ __device__ void init(int M, int N, int G_, int c_, int wgm_ = WGM, int flip_ = 0) { nM = M / BM; nN = N / BM; nwg = nM * nN; G = G_; c = c_; wgm = wgm_; flip = flip_; }
    __host__ __device__ bool next(int i, Unit& u) const {
        const int R = (nwg + G - 1) / G; if (i >= R) return false; const long L = (long)(flip ? R - 1 - i : i) * G + c; if (L >= nwg) return false;
        int wgid = (int)L; { const int q = nwg / NXCD, r = nwg % NXCD, xcd = wgid % NXCD, off = wgid / NXCD; wgid = (xcd < r ? xcd * (q + 1) : r * (q + 1) + (xcd - r) * q) + off; }
        const int nig = wgm * nN, gid = wgid / nig, fm = gid * wgm, gsz = (nM - fm) < wgm ? (nM - fm) : wgm;
        u.pm = fm + ((wgid % nig) % gsz); u.pn = (wgid % nig) / gsz; return true;
    }
    __device__ __forceinline__ void a_ready(const Unit&) const {}
    __device__ __forceinline__ void done(const Unit&) const {}
};

typedef float f32x2 __attribute__((ext_vector_type(2))); typedef __bf16 bf16x2_t __attribute__((ext_vector_type(2)));
__device__ __forceinline__ unsigned cvt_pk_bf16(float lo, float hi) { f32x2 v = {lo, hi}; bf16x2_t b = __builtin_convertvector(v, bf16x2_t); return __builtin_bit_cast(unsigned, b); }
__device__ __forceinline__ float silu_f(float x) { return x * __builtin_amdgcn_rcpf(1.0f + __builtin_amdgcn_exp2f(-1.4426950408889634f * x)); }
struct EpiSwiGLU {
    static constexpr bool PERM = true, AFTER_DRAIN = false;
    struct Pre { unsigned v[8]; };
    __device__ __forceinline__ Pre prefetch(const Unit& u, int wr, int fr) const { Pre p; const unsigned* a = rowsq + u.pm * BM + wr * 64 + fr;
        asm volatile("global_load_dword %0, %8, off\n\tglobal_load_dword %1, %8, off offset:64\n\tglobal_load_dword %2, %8, off offset:128\n\tglobal_load_dword %3, %8, off offset:192\n\tglobal_load_dword %4, %8, off offset:512\n\tglobal_load_dword %5, %8, off offset:576\n\tglobal_load_dword %6, %8, off offset:640\n\tglobal_load_dword %7, %8, off offset:704"
            : "=&v"(p.v[0]), "=&v"(p.v[1]), "=&v"(p.v[2]), "=&v"(p.v[3]), "=&v"(p.v[4]), "=&v"(p.v[5]), "=&v"(p.v[6]), "=&v"(p.v[7]) : "v"(a) : "memory"); return p; }
    bf16_t* O; int ldc; const unsigned* rowsq;
    __device__ __forceinline__ void operator()(const f32x4 (&acc)[2][2][4][2], const Unit& u, int wr, int wc, int fr, int fq, const Pre& pre) const {
        const int row0 = u.pm * BM + wr * 64 + fr, col0 = u.pn * HALF + wc * 32 + 8 * fq;
        float rs[2][4];
#pragma unroll
        for (int ai = 0; ai < 2; ++ai)
#pragma unroll
            for (int m = 0; m < 4; ++m) rs[ai][m] = rsqrtf((float)pre.v[ai * 4 + m] * (1.0f / (2048.0f * 4096.0f)) + 1e-6f);
#pragma unroll
        for (int ai = 0; ai < 2; ++ai)
#pragma unroll
            for (int m = 0; m < 4; ++m) { bf16_t* rowp = O + (size_t)(row0 + ai * HALF + m * 16) * ldc + col0;
                const f32x4 g0 = acc[ai][0][m][0] * rs[ai][m], g1 = acc[ai][0][m][1] * rs[ai][m], u0 = acc[ai][1][m][0] * rs[ai][m], u1 = acc[ai][1][m][1] * rs[ai][m];
                u32x4 w; w.x = cvt_pk_bf16(silu_f(g0[0]) * u0[0], silu_f(g0[1]) * u0[1]); w.y = cvt_pk_bf16(silu_f(g0[2]) * u0[2], silu_f(g0[3]) * u0[3]);
                w.z = cvt_pk_bf16(silu_f(g1[0]) * u1[0], silu_f(g1[1]) * u1[1]); w.w = cvt_pk_bf16(silu_f(g1[2]) * u1[2], silu_f(g1[3]) * u1[3]);
                *(u32x4*)rowp = w; }
    }
};
struct EpiResid {
    static constexpr bool PERM = false, AFTER_DRAIN = false;
    struct Pre {};
    __device__ __forceinline__ Pre prefetch(const Unit&, int, int) const { return Pre{}; }
    const float* base; float* out; bf16_t* hb; unsigned* rowsq; int ldc; float scale;
    __device__ __forceinline__ void operator()(const f32x4 (&acc)[2][2][4][2], const Unit& u, int wr, int wc, int fr, int fq, const Pre&) const {
        typedef unsigned u32x2 __attribute__((ext_vector_type(2)));
        const int row0 = u.pm * BM + wr * 64 + fr, col0 = u.pn * BM + wc * 32 + 4 * fq;
        float ssv[2][4];
#pragma unroll
        for (int ai = 0; ai < 2; ++ai) {
            f32x4 bs[4][2][2];
#pragma unroll
            for (int m = 0; m < 4; ++m) { const unsigned off = (unsigned)(row0 + ai * HALF + m * 16) * (unsigned)ldc + (unsigned)col0;
#pragma unroll
                for (int bj = 0; bj < 2; ++bj)
#pragma unroll
                    for (int n = 0; n < 2; ++n) bs[m][bj][n] = *(const f32x4*)(base + off + bj * HALF + n * 16); }
            asm volatile("" ::: "memory");
#pragma unroll
            for (int m = 0; m < 4; ++m) { const unsigned off = (unsigned)(row0 + ai * HALF + m * 16) * (unsigned)ldc + (unsigned)col0; float ss = 0.f;
#pragma unroll
                for (int bj = 0; bj < 2; ++bj)
#pragma unroll
                    for (int n = 0; n < 2; ++n) { const f32x4 v = bs[m][bj][n] + acc[ai][bj][m][n] * scale;
                        *(f32x4*)(out + off + bj * HALF + n * 16) = v; *(u32x2*)(hb + off + bj * HALF + n * 16) = (u32x2){cvt_pk_bf16(v[0], v[1]), cvt_pk_bf16(v[2], v[3])};
                        ss += (v[0] * v[0] + v[1] * v[1]) + (v[2] * v[2] + v[3] * v[3]); }
                ssv[ai][m] = ss; }
            asm volatile("" ::: "memory");
        }
#pragma unroll
        for (int ai = 0; ai < 2; ++ai)
#pragma unroll
            for (int m = 0; m < 4; ++m) { float ss = ssv[ai][m]; ss += __shfl_xor(ss, 16); ss += __shfl_xor(ss, 32);
                if (fq == 0) (void)__hip_atomic_fetch_add(rowsq + row0 + ai * HALF + m * 16, (unsigned)(ss * 4096.0f + 0.5f), __ATOMIC_RELAXED, __HIP_MEMORY_SCOPE_AGENT); }
    }
};
struct EpiProj {
    static constexpr bool PERM = true, AFTER_DRAIN = false;
    struct Pre { unsigned v[8]; };
    __device__ __forceinline__ Pre prefetch(const Unit& u, int wr, int fr) const { Pre p; const unsigned* a = rowsq + u.pm * BM + wr * 64 + fr;
        asm volatile("global_load_dword %0, %8, off\n\tglobal_load_dword %1, %8, off offset:64\n\tglobal_load_dword %2, %8, off offset:128\n\tglobal_load_dword %3, %8, off offset:192\n\tglobal_load_dword %4, %8, off offset:512\n\tglobal_load_dword %5, %8, off offset:576\n\tglobal_load_dword %6, %8, off offset:640\n\tglobal_load_dword %7, %8, off offset:704"
            : "=&v"(p.v[0]), "=&v"(p.v[1]), "=&v"(p.v[2]), "=&v"(p.v[3]), "=&v"(p.v[4]), "=&v"(p.v[5]), "=&v"(p.v[6]), "=&v"(p.v[7]) : "v"(a) : "memory"); return p; }
    bf16_t* O; int ldc; const unsigned* rowsq;
    __device__ __forceinline__ void operator()(const f32x4 (&acc)[2][2][4][2], const Unit& u, int wr, int wc, int fr, int fq, const Pre& pre) const {
        const int row0 = u.pm * BM + wr * 64 + fr, col0 = u.pn * BM + wc * 32 + 8 * fq;
#pragma unroll
        for (int ai = 0; ai < 2; ++ai)
#pragma unroll
            for (int m = 0; m < 4; ++m) { bf16_t* rowp = O + (size_t)(row0 + ai * HALF + m * 16) * ldc + col0;
                const float rs = rsqrtf((float)pre.v[ai * 4 + m] * (1.0f / (2048.0f * 4096.0f)) + 1e-6f);
#pragma unroll
                for (int bj = 0; bj < 2; ++bj) { const f32x4 v0 = acc[ai][bj][m][0] * rs, v1 = acc[ai][bj][m][1] * rs;
                    u32x4 w; w.x = cvt_pk_bf16(v0[0], v0[1]); w.y = cvt_pk_bf16(v0[2], v0[3]); w.z = cvt_pk_bf16(v1[0], v1[1]); w.w = cvt_pk_bf16(v1[2], v1[3]);
                    *(u32x4*)(rowp + bj * HALF) = w; } }
    }
};
template <class Epi, class Sched, bool ALIGN_EPI = false, bool SP2 = false>
__device__ __forceinline__ void gemm_phase(PG8_LAS unsigned char* lds, const Gemm g, const Sched S, const Epi E, int wv) {
    const int tid = tid_fresh(wv), wid = __builtin_amdgcn_readfirstlane(tid >> 6), lane = tid & 63, wr = wid >> 2, wc = wid & 3, fr = lane & 15, fq = lane >> 4;
    const int K = g.K, nt = K / BK;
    unsigned voffA[2], voffB[2];
#pragma unroll
    for (int i = 0; i < 2; ++i) { int R, C; stage_rc(tid * 16 + i * 8192, R, C); const int Rb = Epi::PERM ? ((R & ~31) + perm32(R & 31)) : R;
        voffA[i] = (unsigned)(R * K + C) * 2u; voffB[i] = (unsigned)(Rb * K + C) * 2u; }
    const size_t kstep = (size_t)(BK * 2);
    const size_t hstep = (size_t)HALF * K * 2;
    const size_t tstep = 2 * hstep;
    const unsigned ldsw = (unsigned)wid * 1024u;
    const int aoff = lds_byte(wr * 64 + fr, fq * 8), boff = lds_byte(wc * 32 + fr, fq * 8);
#define PG8_SA(b, h) (((b) * 2 + (h)) * HTB)
#define PG8_SB(b, h) ((4 + (b) * 2 + (h)) * HTB)
#define PG8_STAGE(bufoff, gbase, voff) do { _Pragma("unroll") for (int _i = 0; _i < 2; ++_i) \
        __builtin_amdgcn_global_load_lds((const unsigned*)((const char*)(gbase) + (voff)[_i]), (PG8_LAS unsigned*)(lds + (bufoff) + ldsw + _i * 8192), 16, 0, 0); } while (0)
#define PG8_LDA(dst, b, h) do { _Pragma("unroll") for (int m = 0; m < 4; ++m) _Pragma("unroll") for (int k = 0; k < 2; ++k) dst[m][k] = *(const PG8_LAS bf16x8*)(lds + PG8_SA(b, h) + aoff + m * 2048 + k * 1024); } while (0)
#define PG8_LDB(dst, b, h) do { _Pragma("unroll") for (int n = 0; n < 2; ++n) _Pragma("unroll") for (int k = 0; k < 2; ++k) dst[n][k] = *(const PG8_LAS bf16x8*)(lds + PG8_SB(b, h) + boff + n * 2048 + k * 1024); } while (0)
#define PG8_MMA(ai, bj, At, Bt) do { __builtin_amdgcn_s_setprio(1); _Pragma("unroll") for (int m = 0; m < 4; ++m) _Pragma("unroll") for (int n = 0; n < 2; ++n) _Pragma("unroll") for (int k = 0; k < 2; ++k) \
        acc[ai][bj][m][n] = __builtin_amdgcn_mfma_f32_16x16x32_bf16(Bt[n][k], At[m][k], acc[ai][bj][m][n], 0, 0, 0); __builtin_amdgcn_s_setprio(0); } while (0)
#define PG8_WAIT_V(n) asm volatile("s_waitcnt vmcnt(" #n ")" ::: "memory")
#define PG8_WAIT_L(n) asm volatile("s_waitcnt lgkmcnt(" #n ")" ::: "memory")
#define PG8_BAR __builtin_amdgcn_s_barrier()
#define PG8_SCHED __builtin_amdgcn_sched_barrier(0)
    Unit cur, nxt; int ui = 0;
    if (!S.next(0, cur)) return;
    f32x4 acc[2][2][4][2];
#pragma unroll
    for (int a = 0; a < 2; ++a)
#pragma unroll
        for (int b = 0; b < 2; ++b)
#pragma unroll
            for (int m = 0; m < 4; ++m)
#pragma unroll
                for (int n = 0; n < 2; ++n) acc[a][b][m][n] = (f32x4){0.f, 0.f, 0.f, 0.f};
    bf16x8 At[4][2], B0[2][2], B1[2][2];
    const char* cA = (const char*)g.A + (size_t)cur.pm * tstep; const char* cB = (const char*)g.Bt + (size_t)cur.pn * tstep;
    S.a_ready(cur);
    typename Epi::Pre pre = E.prefetch(cur, wr, fr);
    if constexpr (SP2) {
        PG8_STAGE(PG8_SB(0, 0), cB, voffB); PG8_STAGE(PG8_SB(0, 1), cB + hstep, voffB); PG8_STAGE(PG8_SA(0, 0), cA, voffA); PG8_STAGE(PG8_SA(0, 1), cA + hstep, voffA);
        if (wr == 1) PG8_BAR;
        PG8_WAIT_V(2); PG8_BAR;
        PG8_STAGE(PG8_SB(1, 0), cB + kstep, voffB); PG8_STAGE(PG8_SA(1, 0), cA + kstep, voffA); PG8_STAGE(PG8_SB(1, 1), cB + hstep + kstep, voffB);
        PG8_WAIT_V(6); PG8_BAR;
    } else {
        PG8_STAGE(PG8_SB(0, 0), cB, voffB); PG8_STAGE(PG8_SA(0, 0), cA, voffA); PG8_STAGE(PG8_SB(0, 1), cB + hstep, voffB); PG8_STAGE(PG8_SA(0, 1), cA + hstep, voffA);
        if (wr == 1) PG8_BAR;
        PG8_WAIT_V(4); PG8_BAR;
        PG8_STAGE(PG8_SB(1, 0), cB + kstep, voffB); PG8_STAGE(PG8_SA(1, 0), cA + kstep, voffA); PG8_STAGE(PG8_SB(1, 1), cB + hstep + kstep, voffB);
        PG8_WAIT_V(6); PG8_BAR;
    }
    for (;;) {
        const bool has_next = S.next(ui + 1, nxt);
        const char* nA = has_next ? (const char*)g.A + (size_t)nxt.pm * tstep : cA; const char* nB = has_next ? (const char*)g.Bt + (size_t)nxt.pn * tstep : cB;
        for (int t = 0; t < nt; t += 2) {
            const bool last = (t == nt - 2);
            const char* a1 = cA + (size_t)(t + 1) * kstep;
            const char* a2 = last ? nA : cA + (size_t)(t + 2) * kstep; const char* b2 = last ? nB : cB + (size_t)(t + 2) * kstep;
            const char* a3 = a2 + kstep; const char* b3 = b2 + kstep;
            if (last && has_next) S.a_ready(nxt);
            if constexpr (SP2) {
            PG8_LDB(B0, 0, 0); PG8_LDB(B1, 0, 1); PG8_SCHED; PG8_LDA(At, 0, 0); PG8_STAGE(PG8_SA(1, 1), a1 + hstep, voffA);
            PG8_WAIT_V(8); PG8_WAIT_L(0); PG8_BAR; PG8_MMA(0, 0, At, B0); PG8_MMA(0, 1, At, B1); PG8_BAR; PG8_SCHED;
            PG8_LDA(At, 0, 1); PG8_STAGE(PG8_SB(0, 0), b2, voffB); PG8_STAGE(PG8_SB(0, 1), b2 + hstep, voffB); PG8_STAGE(PG8_SA(0, 0), a2, voffA);
            PG8_WAIT_V(8); PG8_WAIT_L(0); PG8_BAR; PG8_MMA(1, 0, At, B0); PG8_MMA(1, 1, At, B1); PG8_BAR; PG8_SCHED;
            PG8_LDB(B0, 1, 0); PG8_LDB(B1, 1, 1); PG8_SCHED; PG8_LDA(At, 1, 0); PG8_STAGE(PG8_SA(0, 1), a2 + hstep, voffA);
            PG8_WAIT_V(8); PG8_WAIT_L(0); PG8_BAR; PG8_MMA(0, 0, At, B0); PG8_MMA(0, 1, At, B1); PG8_BAR; PG8_SCHED;
            PG8_LDA(At, 1, 1); PG8_STAGE(PG8_SB(1, 0), b3, voffB); PG8_STAGE(PG8_SB(1, 1), b3 + hstep, voffB); PG8_STAGE(PG8_SA(1, 0), a3, voffA);
            PG8_WAIT_V(8); PG8_WAIT_L(0); PG8_BAR; PG8_MMA(1, 0, At, B0); PG8_MMA(1, 1, At, B1); PG8_BAR; PG8_SCHED;
            } else {
            PG8_LDB(B0, 0, 0); PG8_SCHED; PG8_LDA(At, 0, 0); PG8_STAGE(PG8_SA(1, 1), a1 + hstep, voffA);
            PG8_WAIT_L(8); PG8_BAR; PG8_WAIT_L(0); PG8_MMA(0, 0, At, B0); PG8_BAR; PG8_SCHED;
            PG8_LDB(B1, 0, 1); PG8_STAGE(PG8_SB(0, 0), b2, voffB);
            PG8_BAR; PG8_WAIT_L(0); PG8_MMA(0, 1, At, B1); PG8_BAR;
            PG8_LDA(At, 0, 1); PG8_STAGE(PG8_SA(0, 0), a2, voffA);
            PG8_BAR; PG8_WAIT_L(0); PG8_MMA(1, 0, At, B0); PG8_BAR; PG8_SCHED;
            PG8_STAGE(PG8_SB(0, 1), b2 + hstep, voffB);
            PG8_WAIT_V(6); PG8_BAR; PG8_MMA(1, 1, At, B1); PG8_BAR;
            PG8_LDB(B0, 1, 0); PG8_SCHED; PG8_LDA(At, 1, 0); PG8_STAGE(PG8_SA(0, 1), a2 + hstep, voffA);
            PG8_WAIT_L(8); PG8_BAR; PG8_WAIT_L(0); PG8_MMA(0, 0, At, B0); PG8_BAR; PG8_SCHED;
            PG8_LDB(B1, 1, 1); PG8_STAGE(PG8_SB(1, 0), b3, voffB);
            PG8_BAR; PG8_WAIT_L(0); PG8_MMA(0, 1, At, B1); PG8_BAR;
            PG8_LDA(At, 1, 1); PG8_STAGE(PG8_SA(1, 0), a3, voffA);
            PG8_BAR; PG8_WAIT_L(0); PG8_MMA(1, 0, At, B0); PG8_BAR; PG8_SCHED;
            PG8_STAGE(PG8_SB(1, 1), b3 + hstep, voffB);
            PG8_WAIT_V(6); PG8_BAR; PG8_MMA(1, 1, At, B1); PG8_BAR;
            }
        }
        if constexpr (ALIGN_EPI) { if (wr == 0) PG8_BAR; }
        if constexpr (!Epi::AFTER_DRAIN) { E(acc, cur, wr, wc, fr, fq, pre); S.done(cur); }
        if (!has_next) break;
#pragma unroll
        for (int a = 0; a < 2; ++a)
#pragma unroll
            for (int b = 0; b < 2; ++b)
#pragma unroll
                for (int m = 0; m < 4; ++m)
#pragma unroll
                    for (int n = 0; n < 2; ++n) acc[a][b][m][n] = (f32x4){0.f, 0.f, 0.f, 0.f};
        cur = nxt; cA = nA; cB = nB; ++ui;
        pre = E.prefetch(cur, wr, fr);
        if constexpr (ALIGN_EPI) { if (wr == 1) PG8_BAR; }
    }
    PG8_WAIT_V(0);
    if constexpr (!ALIGN_EPI) { if (wr == 0) PG8_BAR; }
    PG8_BAR;
    if constexpr (Epi::AFTER_DRAIN) { E.fused(acc, cur, wr, wc, fr, fq, lds, wid, lane); S.done(cur); }
#undef PG8_SA
#undef PG8_SB
#undef PG8_STAGE
#undef PG8_LDA
#undef PG8_LDB
#undef PG8_MMA
#undef PG8_WAIT_V
#undef PG8_WAIT_L
#undef PG8_BAR
#undef PG8_SCHED
}
}
#define LAS __attribute__((address_space(3)))
typedef unsigned short bf16;
typedef unsigned v4u __attribute__((ext_vector_type(4)));
typedef unsigned v2u __attribute__((ext_vector_type(2)));
typedef float f32x4 __attribute__((ext_vector_type(4)));
typedef short bf16x8 __attribute__((ext_vector_type(8)));
typedef short s16x4 __attribute__((ext_vector_type(4)));
typedef short v4i16_t __attribute__((ext_vector_type(4)));
typedef float f32x16 __attribute__((ext_vector_type(16)));

constexpr int NB = 8, T = 2048, M = NB * T, D = 2048, FF = 5632, NGU = 2 * FF, NPJ = 7168, NPJ_PAD = 7424, NIN = 7184, NCH = 16;
constexpr int PQ_MQ = 0, PQ_MK = 512, PQ_MV = 1024, PQ_MO = 1536, PQ_NQ = 2048, PQ_NK = 3072, PQ_NV = 4096, PQ_RQ = 5120, PQ_RK = 5632, PQ_RV = 6144, PQ_RG = 6656;
constexpr float EPS = 1e-6f, NEGF = -1e30f, LOG2E = 1.4426950408889634f, QSCALE = 0.08838834764831845f;
constexpr size_t MiB = 1u << 20;
constexpr size_t WS_WGU = 1 * MiB;
constexpr size_t SZ_WGU = (size_t)NGU * D * 2;
constexpr size_t WS_WDN = WS_WGU + 2 * SZ_WGU;
constexpr size_t SZ_WDN = (size_t)D * FF * 2;
constexpr size_t WS_WIN = WS_WDN + 2 * SZ_WDN;
constexpr size_t WS_WOUT = WS_WIN + (size_t)NPJ_PAD * D * 2;
constexpr size_t WS_XN = WS_WOUT + (size_t)D * D * 2;
constexpr size_t WS_PROJ = WS_XN + (size_t)M * D * 2;
constexpr size_t WS_GATES = WS_PROJ + (size_t)M * NPJ * 2;
constexpr size_t WS_CLOC = WS_GATES + (size_t)M * 16 * 4;
constexpr size_t WS_CST = WS_CLOC + (size_t)2048 * 16384 * 4;
constexpr size_t WS_NLOC = WS_CST + (size_t)2048 * 16384 * 2;
constexpr size_t WS_NST = WS_NLOC + (size_t)1024 * 128 * 4;
constexpr size_t WS_MLOC = WS_NST + (size_t)1024 * 128 * 4;
constexpr size_t WS_GTOT = WS_MLOC + 4096;
constexpr size_t WS_MST = WS_GTOT + 4096;
constexpr size_t WS_ROWSQ = WS_MST + 4096;
constexpr size_t WS_MQK = WS_ROWSQ + (size_t)9 * M * 4;
constexpr size_t WS_END = WS_MQK + (size_t)M * 1024 * 2;
static_assert(WS_END < (size_t)690 * MiB, "workspace map");

struct Params { const float* in[18]; float* out; unsigned char* ws; };
enum { I_X = 0, I_F1N, I_F1GU, I_F1DN, I_MIXN, I_WIN, I_CONVW, I_CONVB, I_GATEB, I_MHN, I_RPB, I_DECAY, I_RHN, I_WOUT, I_F2N, I_F2GU, I_F2DN, I_FINN };

constexpr int LDS_BYTES = 148480, MISC_OFF = 147712, GRID = 256;
constexpr int IMG_STRIDE = 288;
constexpr int IMG_BYTES = 128 * IMG_STRIDE;
constexpr int CT_STRIDE = 272, CT_BYTES = 128 * CT_STRIDE;
constexpr int LDS_IMG0 = 0, LDS_IMG1 = IMG_BYTES, LDS_IMG2 = 2 * IMG_BYTES, LDS_CT0 = 2 * IMG_BYTES, LDS_SCAL = 2 * IMG_BYTES + 2 * CT_BYTES;
static_assert(3 * IMG_BYTES <= LDS_SCAL && LDS_SCAL + 1056 * 4 <= MISC_OFF && MISC_OFF + 128 <= LDS_BYTES, "LDS map");

__device__ __forceinline__ float bf2f(unsigned short b) { return __uint_as_float((unsigned)b << 16); }
__device__ __forceinline__ unsigned pk2(float lo, float hi) { return pg8::cvt_pk_bf16(lo, hi); }
__device__ __forceinline__ float lo2f(unsigned w) { return __uint_as_float(w << 16); }
__device__ __forceinline__ float hi2f(unsigned w) { return __uint_as_float(w & 0xffff0000u); }
__device__ __forceinline__ float wave_sum(float v) {
#pragma unroll
    for (int o = 1; o < 64; o <<= 1) v += __shfl_xor(v, o);
    return v;
}
__device__ __forceinline__ float wave_max(float v) {
#pragma unroll
    for (int o = 1; o < 64; o <<= 1) v = fmaxf(v, __shfl_xor(v, o));
    return v;
}
__device__ __forceinline__ float silu_f(float x) { return pg8::silu_f(x); }
__device__ __forceinline__ float sigmoid_f(float x) { return __builtin_amdgcn_rcpf(1.0f + __builtin_amdgcn_exp2f(-LOG2E * x)); }
__device__ __forceinline__ float logsig_f(float x) { return fminf(x, 0.f) - log1pf(expf(-fabsf(x))); }
__device__ __forceinline__ float exp_f(float x) { return __builtin_amdgcn_exp2f(x * LOG2E); }
__device__ __forceinline__ s16x4 tr_read(const LAS unsigned char* p) { return __builtin_bit_cast(s16x4, __builtin_amdgcn_ds_read_tr16_b64_v4i16((LAS v4i16_t*)p)); }
#define LDS_WAIT() asm volatile("s_waitcnt lgkmcnt(0)" ::: "memory")

template <int MAP> __device__ __forceinline__ int map_row(int n) {
    if (MAP == 1) { const int bj = n >= FF ? 1 : 0, j = n - bj * FF; return (j >> 7) * 256 + bj * 128 + (j & 127); }
    if (MAP == 2) { return n < 2048 ? n : (n < 2064 ? NPJ + (n - 2048) : n - 16); }
    return n;
}
template <int MAP> __device__ __forceinline__ void transpose_item(const float* __restrict__ W, int K, int N, bf16* __restrict__ WT, LAS float* scr, int item, int lane, const float* __restrict__ gain) {
    const int nblk = (N + 31) / 32, kb = item / nblk, nb = item - kb * nblk, k0 = 64 * kb, n0 = 32 * nb;
    const int nn = n0 + (lane & 31); const bool ok = nn < N;
    const float* src = W + (size_t)(k0 + (lane >> 5)) * N + (ok ? nn : 0);
#pragma unroll 16
    for (int i = 0; i < 32; ++i) { const float v = src[(size_t)(2 * i) * N]; scr[(2 * i + (lane >> 5)) * 33 + (lane & 31)] = ok ? v : 0.f; }
    LDS_WAIT(); asm volatile("" ::: "memory");
    const int c = lane & 7;
    f32x4 g0 = {1.f, 1.f, 1.f, 1.f}, g1 = {1.f, 1.f, 1.f, 1.f};
    if (gain) { g0 = *(const f32x4*)(gain + k0 + 8 * c); g1 = *(const f32x4*)(gain + k0 + 8 * c + 4); }
#pragma unroll
    for (int j = 0; j < 4; ++j) { const int n = (lane >> 3) + 8 * j; const LAS float* s = scr + (8 * c) * 33 + n;
        v4u o; o.x = pk2(s[0 * 33] * g0.x, s[1 * 33] * g0.y); o.y = pk2(s[2 * 33] * g0.z, s[3 * 33] * g0.w); o.z = pk2(s[4 * 33] * g1.x, s[5 * 33] * g1.y); o.w = pk2(s[6 * 33] * g1.z, s[7 * 33] * g1.w);
        if (n0 + n < N) *(v4u*)(WT + (size_t)map_row<MAP>(n0 + n) * K + k0 + 8 * c) = o; }
    LDS_WAIT(); asm volatile("" ::: "memory");
}
__device__ __forceinline__ void convert_weights(const Params& P, int l, LAS unsigned char* lds, int wv) {
    const int tid = tid_fresh(wv), lane = tid & 63, wave = tid >> 6;
    LAS float* scr = (LAS float*)(lds + wave * 8448);
    const int gw = blockIdx.x * 8 + wave, NGW = GRID * 8;
    bf16* wgu = (bf16*)(P.ws + WS_WGU); bf16* wdn = (bf16*)(P.ws + WS_WDN); bf16* win = (bf16*)(P.ws + WS_WIN); bf16* wout = (bf16*)(P.ws + WS_WOUT);
    constexpr int I_GU = (D / 64) * (NGU / 32), I_DN = (FF / 64) * (D / 32), I_IN = (D / 64) * ((NIN + 31) / 32), I_OUT = (D / 64) * (D / 32);
    constexpr int NITEMS = 2 * I_GU + 2 * I_DN + I_IN + I_OUT;
#pragma unroll 1
    for (int it = gw; it < NITEMS; it += NGW) {
        int r = it;
        if (r < I_GU) { transpose_item<1>(P.in[I_F1GU] + (size_t)l * D * NGU, D, NGU, wgu, scr, r, lane, P.in[I_F1N] + (size_t)l * D); continue; } r -= I_GU;
        if (r < I_GU) { transpose_item<1>(P.in[I_F2GU] + (size_t)l * D * NGU, D, NGU, wgu + (size_t)NGU * D, scr, r, lane, P.in[I_F2N] + (size_t)l * D); continue; } r -= I_GU;
        if (r < I_DN) { transpose_item<0>(P.in[I_F1DN] + (size_t)l * FF * D, FF, D, wdn, scr, r, lane, nullptr); continue; } r -= I_DN;
        if (r < I_DN) { transpose_item<0>(P.in[I_F2DN] + (size_t)l * FF * D, FF, D, wdn + (size_t)D * FF, scr, r, lane, nullptr); continue; } r -= I_DN;
        if (r < I_IN) { transpose_item<2>(P.in[I_WIN] + (size_t)l * D * NIN, D, NIN, win, scr, r, lane, P.in[I_MIXN] + (size_t)l * D); continue; } r -= I_IN;
        transpose_item<0>(P.in[I_WOUT] + (size_t)l * D * D, D, D, wout, scr, r, lane, nullptr);
    }
}
__device__ __forceinline__ void cast_rows_bf16(const float* src, bf16* dst, unsigned* rowsq, int wv) {
    const int tid = tid_fresh(wv), lane = tid & 63, wave = tid >> 6, gw = blockIdx.x * 8 + wave, NGW = GRID * 8;
#pragma unroll 1
    for (int m = gw; m < M; m += NGW) {
        const f32x4* xr = (const f32x4*)(src + (size_t)m * D) + lane;
        f32x4 v[8]; float s = 0.f;
#pragma unroll
        for (int j = 0; j < 8; ++j) { v[j] = xr[64 * j]; s += (v[j].x * v[j].x + v[j].y * v[j].y) + (v[j].z * v[j].z + v[j].w * v[j].w); }
        s = wave_sum(s);
        v2u* o = (v2u*)(dst + (size_t)m * D) + lane;
#pragma unroll
        for (int j = 0; j < 8; ++j) o[64 * j] = (v2u){pk2(v[j].x, v[j].y), pk2(v[j].z, v[j].w)};
        if (lane == 0) rowsq[m] = (unsigned)(s * 4096.0f + 0.5f);
    }
}
__device__ __forceinline__ void rms_rows_f32(const float* src, const float* __restrict__ gain, float* dst, int wv) {
    const int tid = tid_fresh(wv), lane = tid & 63, wave = tid >> 6, gw = blockIdx.x * 8 + wave, NGW = GRID * 8;
    f32x4 gv[8];
#pragma unroll
    for (int j = 0; j < 8; ++j) gv[j] = *(const f32x4*)(gain + 4 * lane + 256 * j);
#pragma unroll 1
    for (int m = gw; m < M; m += NGW) {
        const f32x4* xr = (const f32x4*)(src + (size_t)m * D) + lane;
        f32x4 v[8]; float s = 0.f;
#pragma unroll
        for (int j = 0; j < 8; ++j) { v[j] = xr[64 * j]; s += (v[j].x * v[j].x + v[j].y * v[j].y) + (v[j].z * v[j].z + v[j].w * v[j].w); }
        const float rstd = rsqrtf(wave_sum(s) * (1.f / D) + EPS);
        f32x4* o = (f32x4*)(dst + (size_t)m * D) + lane;
#pragma unroll
        for (int j = 0; j < 8; ++j) o[64 * j] = v[j] * rstd * gv[j];
    }
}
__device__ __forceinline__ size_t st_idx(int typ, int b, int h, int dir, int oc) { return ((((size_t)typ * 8 + b) * 4 + h) * 2 + dir) * 16 + oc; }
__device__ __forceinline__ bf16x8 tr_frag32(const LAS unsigned char* img, int s0, int c0, int lane) {
    const int hh = lane >> 5, grp = (lane >> 4) & 1, q = (lane & 15) >> 2, p = lane & 3;
    const LAS unsigned char* a = img + (s0 + 8 * hh + q) * IMG_STRIDE + (c0 + 16 * grp + 4 * p) * 2;
    const s16x4 lo = tr_read(a), hi = tr_read(a + 4 * IMG_STRIDE);
    return (bf16x8){lo[0], lo[1], lo[2], lo[3], hi[0], hi[1], hi[2], hi[3]};
}
__device__ __forceinline__ bf16x8 tr_frag16p(const LAS unsigned char* img, int stride, int s0, int c0, int lane) {
    const int g = lane >> 4, q = (lane & 15) >> 2, p = lane & 3;
    const LAS unsigned char* a = img + (s0 + 4 * g + q) * stride + (c0 + 4 * p) * 2;
    const s16x4 lo = tr_read(a), hi = tr_read(a + 16 * stride);
    return (bf16x8){lo[0], lo[1], lo[2], lo[3], hi[0], hi[1], hi[2], hi[3]};
}
template <bool REV, bool MAXOP> __device__ __forceinline__ void wave_scan128(const LAS float* in, LAS float* out, int lane) {
    const int i0 = REV ? 127 - 2 * lane : 2 * lane, i1 = REV ? 126 - 2 * lane : 2 * lane + 1;
    const float x0 = in[i0], x1 = in[i1];
    const float pr = MAXOP ? fmaxf(x0, x1) : x0 + x1;
    float s = pr;
#pragma unroll
    for (int o = 1; o < 64; o <<= 1) { const float y = __shfl_up(s, o); if (lane >= o) s = MAXOP ? fmaxf(s, y) : s + y; }
    float ex = __shfl_up(s, 1);
    if (MAXOP) { ex = lane ? ex : NEGF; out[i0] = fmaxf(ex, x0); out[i1] = fmaxf(ex, pr); }
    else { ex = lane ? ex : 0.f; out[i0] = ex + x0; out[i1] = ex + pr; }
}
__device__ __forceinline__ void rope_cs(int pos, int idx, float& c, float& s) {
    const float inv = exp2f(-(float)idx * 0.20762050593046014f);
    float r = (float)pos * inv; r *= 0.15915494309189535f; r -= floorf(r);
    c = __builtin_amdgcn_cosf(r); s = __builtin_amdgcn_sinf(r);
}
enum { S_LIF = 0, S_BF = 128, S_LIB = 256, S_BB = 384, S_T0 = 512, S_T1 = 640, S_PMF = 768, S_PMB = 896, S_RED = 1024 };
__device__ __forceinline__ void mlstm_scalars(const Params& P, int l, int b, int h, int oc, LAS float* sc, int wv) {
    const int tid = tid_fresh(wv), lane = tid & 63, wave = tid >> 6;
    if (tid < 128) {
        const float* g = (const float*)(P.ws + WS_GATES) + (size_t)(b * T + oc * 128 + tid) * 16; const float* gb = P.in[I_GATEB] + l * 16;
        sc[S_LIF + tid] = g[h] + gb[h]; sc[S_T0 + tid] = logsig_f(g[4 + h] + gb[4 + h]);
        sc[S_LIB + tid] = g[8 + h] + gb[8 + h]; sc[S_T1 + tid] = logsig_f(g[12 + h] + gb[12 + h]);
    }
    __syncthreads();
    if (wave == 0) wave_scan128<false, false>(sc + S_T0, sc + S_BF, lane);
    if (wave == 1) wave_scan128<true, false>(sc + S_T1, sc + S_BB, lane);
    __syncthreads();
}
template <bool MAXOP> __device__ __forceinline__ void scan2(float x0, float x1, int lane, float& y0, float& y1) {
    const float pr = MAXOP ? fmaxf(x0, x1) : x0 + x1;
    float s = pr;
#pragma unroll
    for (int o = 1; o < 64; o <<= 1) { const float y = __shfl_up(s, o); if (lane >= o) s = MAXOP ? fmaxf(s, y) : s + y; }
    float ex = __shfl_up(s, 1);
    if (MAXOP) { ex = lane ? ex : NEGF; y0 = fmaxf(ex, x0); y1 = fmaxf(ex, pr); }
    else { ex = lane ? ex : 0.f; y0 = ex + x0; y1 = ex + pr; }
}
template <bool REV, int MODE> __device__ __forceinline__ void wave_gate_scalars(const Params& P, int l, int b, int h, int oc, LAS float* sc, int lane, int wofs, int bofs, int pofs, size_t sidx) {
    const int i0 = REV ? 127 - 2 * lane : 2 * lane, i1 = REV ? 126 - 2 * lane : 2 * lane + 1;
    const float* g = (const float*)(P.ws + WS_GATES) + (size_t)(b * T + oc * 128) * 16; const float* gb = P.in[I_GATEB] + l * 16;
    const int ci = (REV ? 8 : 0) + h, cf = (REV ? 12 : 4) + h;
    const float li0 = g[i0 * 16 + ci] + gb[ci], li1 = g[i1 * 16 + ci] + gb[ci];
    const float lf0 = logsig_f(g[i0 * 16 + cf] + gb[cf]), lf1 = logsig_f(g[i1 * 16 + cf] + gb[cf]);
    float b0, b1; scan2<false>(lf0, lf1, lane, b0, b1);
    if (MODE == 0) {
        const float gtot = __shfl(b1, 63);
        const float a0 = gtot - b0 + li0, a1 = gtot - b1 + li1;
        const float mloc = wave_max(fmaxf(a0, a1));
        sc[wofs + i0] = exp_f(a0 - mloc); sc[wofs + i1] = exp_f(a1 - mloc);
        if (lane == 0) { ((float*)(P.ws + WS_MLOC))[sidx] = mloc; ((float*)(P.ws + WS_GTOT))[sidx] = gtot; }
    } else {
        const float u0 = li0 - b0, u1 = li1 - b1;
        float p0, p1; scan2<true>(u0, u1, lane, p0, p1);
        const float cmax = wave_max(fmaxf(u0, u1));
        sc[bofs + i0] = b0; sc[bofs + i1] = b1; sc[wofs + i0] = exp_f(fmaxf(u0 - cmax, -80.f)); sc[wofs + i1] = exp_f(fmaxf(u1 - cmax, -80.f)); sc[pofs + i0] = p0; sc[pofs + i1] = p1;
        if (lane == 0) sc[S_RED + (REV ? 1 : 0)] = cmax;
    }
}
__device__ __forceinline__ void prep_phase(const Params& P, int l, int wv) {
    const int tid = tid_fresh(wv), lane = tid & 63, wave = tid >> 6, gw = blockIdx.x * 8 + wave, NGW = GRID * 8;
    bf16* proj = (bf16*)(P.ws + WS_PROJ); bf16* mqk = (bf16*)(P.ws + WS_MQK);
    const float* cw = P.in[I_CONVW] + (size_t)l * 3 * 1024; const float* cb = P.in[I_CONVB] + (size_t)l * 1024;
#pragma unroll 1
    for (int m = gw; m < M; m += NGW) {
        const int t = m & (T - 1);
#pragma unroll
        for (int half = 0; half < 2; ++half) {
            const int c0 = half * 512 + 8 * lane;
            const f32x4 b0 = *(const f32x4*)(cb + c0), b1 = *(const f32x4*)(cb + c0 + 4);
            float y[8] = {b0.x, b0.y, b0.z, b0.w, b1.x, b1.y, b1.z, b1.w};
#pragma unroll
            for (int j = 0; j < 3; ++j) { const int tt = t + j - 1; const float ok = (tt >= 0 && tt < T) ? 1.f : 0.f; const int mc = m + (tt < 0 ? 0 : (tt >= T ? 0 : j - 1));
                const v4u a = *(const v4u*)(proj + (size_t)mc * NPJ + PQ_MQ + c0);
                const f32x4 w0 = *(const f32x4*)(cw + j * 1024 + c0) * ok, w1 = *(const f32x4*)(cw + j * 1024 + c0 + 4) * ok;
                y[0] += w0.x * lo2f(a.x); y[1] += w0.y * hi2f(a.x); y[2] += w0.z * lo2f(a.y); y[3] += w0.w * hi2f(a.y);
                y[4] += w1.x * lo2f(a.z); y[5] += w1.y * hi2f(a.z); y[6] += w1.z * lo2f(a.w); y[7] += w1.w * hi2f(a.w); }
            const float sc = half ? 1.0f : QSCALE;
            *(v4u*)(mqk + (size_t)m * 1024 + c0) = (v4u){pk2(silu_f(y[0]) * sc, silu_f(y[1]) * sc), pk2(silu_f(y[2]) * sc, silu_f(y[3]) * sc), pk2(silu_f(y[4]) * sc, silu_f(y[5]) * sc), pk2(silu_f(y[6]) * sc, silu_f(y[7]) * sc)};
        }
        { const int isk = lane >> 5, hd = (lane >> 3) & 3, ch = lane & 7;
          bf16* rp = proj + (size_t)m * NPJ + (isk ? PQ_RK : PQ_RQ) + hd * 128 + 8 * ch;
          const v4u a = *(const v4u*)rp, pb = *(const v4u*)(rp + 64);
          const float x1[8] = {lo2f(a.x), hi2f(a.x), lo2f(a.y), hi2f(a.y), lo2f(a.z), hi2f(a.z), lo2f(a.w), hi2f(a.w)};
          const float x2[8] = {lo2f(pb.x), hi2f(pb.x), lo2f(pb.y), hi2f(pb.y), lo2f(pb.z), hi2f(pb.z), lo2f(pb.w), hi2f(pb.w)};
          const float sc = isk ? QSCALE : 1.0f; float o1[8], o2[8];
#pragma unroll
          for (int i = 0; i < 8; ++i) { float c, s; rope_cs(t, 8 * ch + i, c, s); o1[i] = (x1[i] * c - x2[i] * s) * sc; o2[i] = (x1[i] * s + x2[i] * c) * sc; }
          *(v4u*)rp = (v4u){pk2(o1[0], o1[1]), pk2(o1[2], o1[3]), pk2(o1[4], o1[5]), pk2(o1[6], o1[7])};
          *(v4u*)(rp + 64) = (v4u){pk2(o2[0], o2[1]), pk2(o2[2], o2[3]), pk2(o2[4], o2[5]), pk2(o2[6], o2[7])}; }
    }
}
template <bool RET> __device__ __forceinline__ v4u k_packed(const Params& P, int b, int t, int h, int ch) {
    if (RET) return *(const v4u*)((const bf16*)(P.ws + WS_PROJ) + (size_t)(b * T + t) * NPJ + PQ_RK + h * 128 + 8 * ch);
    return *(const v4u*)((const bf16*)(P.ws + WS_MQK) + (size_t)(b * T + t) * 1024 + 512 + h * 128 + 8 * ch);
}
template <bool RET> __device__ __forceinline__ void q_frags(const Params& P, int b, int t, int h, int g, bf16x8 (&qf)[4]) {
    const bf16* qp = RET ? (const bf16*)(P.ws + WS_PROJ) + (size_t)(b * T + t) * NPJ + PQ_RQ + h * 128 + 8 * g : (const bf16*)(P.ws + WS_MQK) + (size_t)(b * T + t) * 1024 + h * 128 + 8 * g;
#pragma unroll
    for (int ks = 0; ks < 4; ++ks) qf[ks] = *(const bf16x8*)(qp + 32 * ks);
}
__device__ __forceinline__ float ret_log2g(const Params& P, int l, int dir, int h) { return logsig_f(P.in[I_DECAY][l * 8 + dir * 4 + h]) * LOG2E; }

template <bool RET> __device__ __forceinline__ void lin_local_unit(const Params& P, int l, int b, int h, int oc, LAS unsigned char* lds, int wv) {
    const int tid = tid_fresh(wv), lane = tid & 63, wave = tid >> 6;
    LAS float* sc = (LAS float*)(lds + LDS_SCAL);
    const bf16* proj = (const bf16*)(P.ws + WS_PROJ);
    const size_t i0 = st_idx(RET ? 1 : 0, b, h, 0, oc), i1 = st_idx(RET ? 1 : 0, b, h, 1, oc);
    v4u vv[4], kp[4];
#pragma unroll
    for (int it = 0; it < 4; ++it) {
        const int id = it * 512 + tid, s = id >> 4, ch = id & 15;
        vv[it] = *(const v4u*)(proj + (size_t)(b * T + oc * 128 + s) * NPJ + (RET ? PQ_RV : PQ_MV) + h * 128 + 8 * ch);
        kp[it] = k_packed<RET>(P, b, oc * 128 + s, h, ch);
    }
    float lgF = 0.f, lgB = 0.f;
    if (RET) { lgF = ret_log2g(P, l, 0, h); lgB = ret_log2g(P, l, 1, h); }
    else {
        if (wave == 0) wave_gate_scalars<false, 0>(P, l, b, h, oc, sc, lane, S_T0, 0, 0, i0);
        if (wave == 1) wave_gate_scalars<true, 0>(P, l, b, h, oc, sc, lane, S_T1, 0, 0, i1);
        __syncthreads();
    }
#pragma unroll
    for (int it = 0; it < 4; ++it) {
        const int id = it * 512 + tid, s = id >> 4, ch = id & 15;
        *(LAS v4u*)(lds + LDS_IMG0 + s * IMG_STRIDE + ch * 16) = vv[it];
        const float wF = RET ? __builtin_amdgcn_exp2f((float)(127 - s) * lgF) : sc[S_T0 + s], wB = RET ? __builtin_amdgcn_exp2f((float)s * lgB) : sc[S_T1 + s];
        const float k[8] = {lo2f(kp[it].x), hi2f(kp[it].x), lo2f(kp[it].y), hi2f(kp[it].y), lo2f(kp[it].z), hi2f(kp[it].z), lo2f(kp[it].w), hi2f(kp[it].w)};
        *(LAS v4u*)(lds + LDS_IMG1 + s * IMG_STRIDE + ch * 16) = (v4u){pk2(k[0] * wF, k[1] * wF), pk2(k[2] * wF, k[3] * wF), pk2(k[4] * wF, k[5] * wF), pk2(k[6] * wF, k[7] * wF)};
        *(LAS v4u*)(lds + LDS_IMG2 + s * IMG_STRIDE + ch * 16) = (v4u){pk2(k[0] * wB, k[1] * wB), pk2(k[2] * wB, k[3] * wB), pk2(k[4] * wB, k[5] * wB), pk2(k[6] * wB, k[7] * wB)};
    }
    __syncthreads();
    const int et = wave & 3, dp = wave >> 2;
    f32x16 acc[2][2];
#pragma unroll
    for (int a = 0; a < 2; ++a)
#pragma unroll
        for (int c = 0; c < 2; ++c)
#pragma unroll
            for (int r = 0; r < 16; ++r) acc[a][c][r] = 0.f;
#pragma unroll 2
    for (int ks = 0; ks < 8; ++ks) {
        const bf16x8 av = tr_frag32(lds + LDS_IMG0, 16 * ks, 32 * et, lane);
#pragma unroll
        for (int dir = 0; dir < 2; ++dir)
#pragma unroll
            for (int c = 0; c < 2; ++c) { const bf16x8 bk = tr_frag32(lds + (dir ? LDS_IMG2 : LDS_IMG1), 16 * ks, 32 * (2 * dp + c), lane);
                acc[dir][c] = __builtin_amdgcn_mfma_f32_32x32x16_bf16(av, bk, acc[dir][c], 0, 0, 0); }
    }
    bf16* ct = (bf16*)(P.ws + WS_CLOC);
#pragma unroll
    for (int dir = 0; dir < 2; ++dir)
#pragma unroll
        for (int c = 0; c < 2; ++c)
#pragma unroll
            for (int r = 0; r < 16; ++r) { const int e = 32 * et + (r & 3) + 8 * (r >> 2) + 4 * (lane >> 5), d = 32 * (2 * dp + c) + (lane & 31);
                ct[(dir ? i1 : i0) * 16384 + (size_t)e * 128 + d] = (bf16)(pk2(acc[dir][c][r], 0.f) & 0xffffu); }
    if (!RET && tid < 256) {
        const int dir = tid >> 7, d = tid & 127; const LAS unsigned short* img = (const LAS unsigned short*)(lds + (dir ? LDS_IMG2 : LDS_IMG1)) + d;
        float s = 0.f;
#pragma unroll 8
        for (int r = 0; r < 128; ++r) s += bf2f(img[r * (IMG_STRIDE / 2)]);
        ((float*)(P.ws + WS_NLOC))[(dir ? i1 : i0) * 128 + d] = s;
    }
    __syncthreads();
}
template <bool RET> __device__ __forceinline__ void lin_out_unit(const Params& P, int l, int b, int h, int oc, LAS unsigned char* lds, int wv) {
    const int tid = tid_fresh(wv), lane = tid & 63, wave = tid >> 6, g = lane >> 4, li = lane & 15;
    LAS float* sc = (LAS float*)(lds + LDS_SCAL);
    const bf16* proj = (const bf16*)(P.ws + WS_PROJ);
    const size_t i0 = st_idx(RET ? 1 : 0, b, h, 0, oc), i1 = st_idx(RET ? 1 : 0, b, h, 1, oc);
    const int tq = 16 * wave + li;
    bf16x8 qf[4]; q_frags<RET>(P, b, oc * 128 + tq, h, g, qf);
    v4u vv[4], kp[4], c0v[4], c1v[4];
    { const bf16* ct0 = (const bf16*)(P.ws + WS_CST) + i0 * 16384; const bf16* ct1 = (const bf16*)(P.ws + WS_CST) + i1 * 16384;
#pragma unroll
      for (int it = 0; it < 4; ++it) { const int id = it * 512 + tid, s = id >> 4, ch = id & 15;
        vv[it] = *(const v4u*)(proj + (size_t)(b * T + oc * 128 + s) * NPJ + (RET ? PQ_RV : PQ_MV) + h * 128 + 8 * ch);
        kp[it] = k_packed<RET>(P, b, oc * 128 + s, h, ch);
        c0v[it] = *(const v4u*)(ct0 + (size_t)s * 128 + 8 * ch); c1v[it] = *(const v4u*)(ct1 + (size_t)s * 128 + 8 * ch); } }
#pragma unroll
    for (int it = 0; it < 4; ++it) { const int id = it * 512 + tid, s = id >> 4, ch = id & 15;
        *(LAS v4u*)(lds + LDS_IMG0 + s * IMG_STRIDE + ch * 16) = vv[it]; *(LAS v4u*)(lds + LDS_IMG1 + s * IMG_STRIDE + ch * 16) = kp[it];
        *(LAS v4u*)(lds + LDS_CT0 + s * CT_STRIDE + ch * 16) = c0v[it]; *(LAS v4u*)(lds + LDS_CT0 + CT_BYTES + s * CT_STRIDE + ch * 16) = c1v[it]; }
    float lgF = 0.f, lgB = 0.f;
    if (!RET) {
        if (wave == 0) wave_gate_scalars<false, 1>(P, l, b, h, oc, sc, lane, S_T0, S_BF, S_PMF, 0);
        if (wave == 1) wave_gate_scalars<true, 1>(P, l, b, h, oc, sc, lane, S_T1, S_BB, S_PMB, 0);
    } else {
        lgF = ret_log2g(P, l, 0, h); lgB = ret_log2g(P, l, 1, h);
        if (tid < 128) { sc[S_T0 + tid] = __builtin_amdgcn_exp2f(-(float)tid * lgF); sc[S_T1 + tid] = __builtin_amdgcn_exp2f((float)tid * lgB); }
    }
    __syncthreads();
    f32x4 sT[8];
#pragma unroll
    for (int kt = 0; kt < 8; ++kt) { f32x4 a = {0.f, 0.f, 0.f, 0.f};
#pragma unroll
        for (int ks = 0; ks < 4; ++ks) { const bf16x8 kf = *(const LAS bf16x8*)(lds + LDS_IMG1 + (16 * kt + li) * IMG_STRIDE + (32 * ks + 8 * g) * 2);
            a = __builtin_amdgcn_mfma_f32_16x16x32_bf16(kf, qf[ks], a, 0, 0, 0); }
        sT[kt] = a; }
    float alF, alB, cF, cB;
    float dmF[4], dmB[4];
#pragma unroll
    for (int j = 0; j < 4; ++j) { const int d = 4 * g + j - li; dmF[j] = d <= 0 ? 1.f : 0.f; dmB[j] = d >= 0 ? 1.f : 0.f; }
    if (RET) {
        cF = __builtin_amdgcn_exp2f((float)tq * lgF); cB = __builtin_amdgcn_exp2f(-(float)tq * lgB);
        alF = __builtin_amdgcn_exp2f((float)(tq + 1) * lgF); alB = __builtin_amdgcn_exp2f((float)(128 - tq) * lgB);
    } else {
        const float mCF = ((const float*)(P.ws + WS_MST))[i0], mCB = ((const float*)(P.ws + WS_MST))[i1];
        const float kapF = fmaxf(mCF, sc[S_PMF + tq]), kapB = fmaxf(mCB, sc[S_PMB + tq]);
        const float mF = kapF + sc[S_BF + tq], mB = kapB + sc[S_BB + tq];
        const float wiF = exp_f(mCF - kapF), wiB = exp_f(mCB - kapB);
        const float RF = exp_f(fminf(sc[S_RED + 0] - kapF, 80.f)), RB = exp_f(fminf(sc[S_RED + 1] - kapB, 80.f));
        float sumF = 0.f, sumB = 0.f;
#pragma unroll
        for (int kt = 0; kt < 8; ++kt) { const f32x4 eF = *(const LAS f32x4*)(sc + S_T0 + 16 * kt + 4 * g), eB = *(const LAS f32x4*)(sc + S_T1 + 16 * kt + 4 * g);
            const float tf = kt < wave ? 1.f : 0.f, te = kt == wave ? 1.f : 0.f, tb = kt > wave ? 1.f : 0.f;
#pragma unroll
            for (int j = 0; j < 4; ++j) { sumF += sT[kt][j] * (eF[j] * (tf + te * dmF[j])); sumB += sT[kt][j] * (eB[j] * (tb + te * dmB[j])); } }
        sumF += __shfl_xor(sumF, 16); sumF += __shfl_xor(sumF, 32); sumB += __shfl_xor(sumB, 16); sumB += __shfl_xor(sumB, 32);
        const float* nF = (const float*)(P.ws + WS_NST) + i0 * 128; const float* nB = (const float*)(P.ws + WS_NST) + i1 * 128;
        float qnF = 0.f, qnB = 0.f;
#pragma unroll
        for (int ks = 0; ks < 4; ++ks) { const f32x4 a0 = *(const f32x4*)(nF + 32 * ks + 8 * g), a1 = *(const f32x4*)(nF + 32 * ks + 8 * g + 4), c0 = *(const f32x4*)(nB + 32 * ks + 8 * g), c1 = *(const f32x4*)(nB + 32 * ks + 8 * g + 4);
            const v4u qw = __builtin_bit_cast(v4u, qf[ks]);
            const float q0 = lo2f(qw.x), q1 = hi2f(qw.x), q2 = lo2f(qw.y), q3 = hi2f(qw.y), q4 = lo2f(qw.z), q5 = hi2f(qw.z), q6 = lo2f(qw.w), q7 = hi2f(qw.w);
            qnF += q0 * a0.x + q1 * a0.y + q2 * a0.z + q3 * a0.w + q4 * a1.x + q5 * a1.y + q6 * a1.z + q7 * a1.w;
            qnB += q0 * c0.x + q1 * c0.y + q2 * c0.z + q3 * c0.w + q4 * c1.x + q5 * c1.y + q6 * c1.z + q7 * c1.w; }
        qnF += __shfl_xor(qnF, 16); qnF += __shfl_xor(qnF, 32); qnB += __shfl_xor(qnB, 16); qnB += __shfl_xor(qnB, 32);
        const float denF = RF * sumF + wiF * qnF, denB = RB * sumB + wiB * qnB;
        const float rF = 1.0f / fmaxf(fabsf(denF), exp_f(-mF)), rB = 1.0f / fmaxf(fabsf(denB), exp_f(-mB));
        cF = RF * rF; cB = RB * rB; alF = rF * wiF; alB = rB * wiB;
    }
#pragma unroll
    for (int kt = 0; kt < 8; ++kt) { const f32x4 eF = *(const LAS f32x4*)(sc + S_T0 + 16 * kt + 4 * g), eB = *(const LAS f32x4*)(sc + S_T1 + 16 * kt + 4 * g);
        const float tf = kt < wave ? cF : 0.f, teF = kt == wave ? cF : 0.f, tb = kt > wave ? cB : 0.f, teB = kt == wave ? cB : 0.f;
#pragma unroll
        for (int j = 0; j < 4; ++j) sT[kt][j] *= eF[j] * (tf + teF * dmF[j]) + eB[j] * (tb + teB * dmB[j]); }
    f32x4 O[8];
#pragma unroll
    for (int et = 0; et < 8; ++et) O[et] = (f32x4){0.f, 0.f, 0.f, 0.f};
#pragma unroll
    for (int ks = 0; ks < 4; ++ks) {
        const v4u pw = {pk2(sT[2 * ks][0], sT[2 * ks][1]), pk2(sT[2 * ks][2], sT[2 * ks][3]), pk2(sT[2 * ks + 1][0], sT[2 * ks + 1][1]), pk2(sT[2 * ks + 1][2], sT[2 * ks + 1][3])};
        const bf16x8 pf = __builtin_bit_cast(bf16x8, pw);
#pragma unroll
        for (int et = 0; et < 8; ++et) { const bf16x8 vf = tr_frag16p(lds + LDS_IMG0, IMG_STRIDE, 32 * ks, 16 * et, lane);
            O[et] = __builtin_amdgcn_mfma_f32_16x16x32_bf16(vf, pf, O[et], 0, 0, 0); }
    }
#pragma unroll
    for (int dir = 0; dir < 2; ++dir) {
        const float al = dir ? alB : alF;
#pragma unroll
        for (int et = 0; et < 8; ++et) { f32x4 x = {0.f, 0.f, 0.f, 0.f};
#pragma unroll
            for (int ks = 0; ks < 4; ++ks) { const bf16x8 cf = *(const LAS bf16x8*)(lds + LDS_CT0 + dir * CT_BYTES + (16 * et + li) * CT_STRIDE + (32 * ks + 8 * g) * 2);
                x = __builtin_amdgcn_mfma_f32_16x16x32_bf16(cf, qf[ks], x, 0, 0, 0); }
            O[et] += x * al; }
    }
    asm volatile("" ::: "memory");
    const size_t row = (size_t)(b * T + oc * 128 + tq);
    const bf16* gp = proj + row * NPJ + (RET ? PQ_RG : PQ_MO) + h * 128 + 4 * g;
    const float* gain = P.in[RET ? I_RHN : I_MHN] + (size_t)l * 512 + h * 128 + 4 * g;
    float gt[8][4]; float ss = 0.f;
#pragma unroll
    for (int et = 0; et < 8; ++et) { const v2u w = *(const v2u*)(gp + 16 * et);
        gt[et][0] = lo2f(w.x); gt[et][1] = hi2f(w.x); gt[et][2] = lo2f(w.y); gt[et][3] = hi2f(w.y);
#pragma unroll
        for (int j = 0; j < 4; ++j) { if (!RET) O[et][j] *= sigmoid_f(gt[et][j]); ss += O[et][j] * O[et][j]; } }
    ss += __shfl_xor(ss, 16); ss += __shfl_xor(ss, 32);
    const float rs = rsqrtf(ss * (1.0f / 128.0f) + EPS);
    bf16* op = (bf16*)(P.ws + WS_XN) + row * D + (RET ? 1536 : 0) + h * 128 + 4 * g;
#pragma unroll
    for (int et = 0; et < 8; ++et) { const f32x4 gn = *(const f32x4*)(gain + 16 * et); f32x4 y = O[et] * rs * gn;
        if (RET) { y[0] *= silu_f(gt[et][0]); y[1] *= silu_f(gt[et][1]); y[2] *= silu_f(gt[et][2]); y[3] *= silu_f(gt[et][3]); }
        *(v2u*)(op + 16 * et) = (v2u){pk2(y[0], y[1]), pk2(y[2], y[3])}; }
    __syncthreads();
}

constexpr int NA_TSTRIDE = 288, NA_TBYTES = 64 * NA_TSTRIDE;
__device__ __forceinline__ void na_block_unit(const Params& P, int l, int u, LAS unsigned char* lds, int wv) {
    const int tid = tid_fresh(wv), lane = tid & 63, wave = tid >> 6, g = lane >> 4, li = lane & 15;
    const int rp = u & 15, head = (u >> 4) & 7, b = u >> 7;
    const int n = wave & 3, r = 2 * rp + (wave >> 2);
    const bf16* proj = (const bf16*)(P.ws + WS_PROJ);
    const int r0a = min(max(2 * rp - 4, 0), 24), r0b = min(max(2 * rp - 3, 0), 24), nrows = r0b + 8 - r0a;
    const int r0 = (wave >> 2) ? r0b : r0a, shift = r0 - r0a;
    const int kc0 = (n == 0) ? 0 : (n == 1) ? 8 : (n == 2) ? 24 : 32;
    const int qc = 16 * n + li;
    const size_t qrow = (size_t)(b * T + r * 64 + qc);
    bf16x8 qf[4];
#pragma unroll
    for (int ks = 0; ks < 4; ++ks) qf[ks] = *(const bf16x8*)(proj + qrow * NPJ + PQ_NQ + head * 128 + 32 * ks + 8 * g);
    LAS float* rpb = (LAS float*)(lds + 2 * NA_TBYTES);
    if (tid < 465) rpb[tid] = P.in[I_RPB][((size_t)l * 8 + head) * 465 + tid];
    const int win0 = min(max(qc - 8, 0), 48);
    int dcv[2][4]; bool okv[2][4];
#pragma unroll
    for (int hf = 0; hf < 2; ++hf)
#pragma unroll
        for (int j = 0; j < 4; ++j) { const int kc = kc0 + 16 * hf + 4 * g + j; okv[hf][j] = kc >= win0 && kc < win0 + 16; dcv[hf][j] = min(max(kc - qc + 15, 0), 30); }
    const bf16* kst = proj + (size_t)(b * T + r0a * 64 + (tid >> 4)) * NPJ + PQ_NK + head * 128 + 8 * (tid & 15);
    const bf16* vst = kst + (PQ_NV - PQ_NK);
    LAS unsigned char* wdst = lds + (tid >> 4) * NA_TSTRIDE + (tid & 15) * 16;
    f32x4 sT[16]; float mx = NEGF;
    __syncthreads();
#pragma unroll
    for (int i = 0; i < 8; ++i)
#pragma unroll
        for (int hf = 0; hf < 2; ++hf)
#pragma unroll
            for (int j = 0; j < 4; ++j) sT[2 * i + hf][j] = rpb[(r0 + i - r + 7) * 31 + dcv[hf][j]] * (1.0f / QSCALE);
    constexpr int NA_PF = 4;
    v4u sq[NA_PF][2];
#pragma unroll
    for (int j = 0; j < NA_PF; ++j) { sq[j][0] = *(const v4u*)(kst + (size_t)(j * 64) * NPJ); sq[j][1] = *(const v4u*)(kst + (size_t)(j * 64 + 32) * NPJ); }
#define NA_SROW(I, BUF) do { \
        _Pragma("unroll") for (int hf = 0; hf < 2; ++hf) { f32x4 a_ = sT[2 * (I) + hf]; \
            _Pragma("unroll") for (int ks = 0; ks < 4; ++ks) { const bf16x8 kf_ = *(const LAS bf16x8*)(lds + (BUF) * NA_TBYTES + (kc0 + 16 * hf + li) * NA_TSTRIDE + (32 * ks + 8 * g) * 2); \
                a_ = __builtin_amdgcn_mfma_f32_16x16x32_bf16(kf_, qf[ks], a_, 0, 0, 0); } \
            _Pragma("unroll") for (int j = 0; j < 4; ++j) { const float s_ = okv[hf][j] ? a_[j] * QSCALE : NEGF; a_[j] = s_; mx = fmaxf(mx, s_); } \
            sT[2 * (I) + hf] = a_; } } while (0)
#pragma unroll
    for (int j = 0; j < 9; ++j) {
        if (j < nrows) {
            *(LAS v4u*)(wdst + (j & 1) * NA_TBYTES) = sq[j % NA_PF][0]; *(LAS v4u*)(wdst + (j & 1) * NA_TBYTES + 32 * NA_TSTRIDE) = sq[j % NA_PF][1];
            if (j + NA_PF < nrows) { sq[j % NA_PF][0] = *(const v4u*)(kst + (size_t)((j + NA_PF) * 64) * NPJ); sq[j % NA_PF][1] = *(const v4u*)(kst + (size_t)((j + NA_PF) * 64 + 32) * NPJ); }
            asm volatile("s_waitcnt lgkmcnt(0)" ::: "memory"); __builtin_amdgcn_s_barrier(); asm volatile("" ::: "memory");
            if (shift == 0) { if (j < 8) NA_SROW(j, j & 1); }
            else { if (j >= 1) NA_SROW(j - 1, j & 1); }
        }
    }
#undef NA_SROW
#pragma unroll
    for (int j = 0; j < NA_PF; ++j) { sq[j][0] = *(const v4u*)(vst + (size_t)(j * 64) * NPJ); sq[j][1] = *(const v4u*)(vst + (size_t)(j * 64 + 32) * NPJ); }
    mx = fmaxf(mx, __shfl_xor(mx, 16)); mx = fmaxf(mx, __shfl_xor(mx, 32));
    float sum = 0.f;
#pragma unroll
    for (int kt = 0; kt < 16; ++kt)
#pragma unroll
        for (int j = 0; j < 4; ++j) { const float p = exp_f(sT[kt][j] - mx); sT[kt][j] = p; sum += p; }
    sum += __shfl_xor(sum, 16); sum += __shfl_xor(sum, 32);
    f32x4 O[8];
#pragma unroll
    for (int et = 0; et < 8; ++et) O[et] = (f32x4){0.f, 0.f, 0.f, 0.f};
    __syncthreads();
#define NA_VROW(I, BUF) do { const v4u pw_ = {pk2(sT[2 * (I)][0], sT[2 * (I)][1]), pk2(sT[2 * (I)][2], sT[2 * (I)][3]), pk2(sT[2 * (I) + 1][0], sT[2 * (I) + 1][1]), pk2(sT[2 * (I) + 1][2], sT[2 * (I) + 1][3])}; \
        const bf16x8 pf_ = __builtin_bit_cast(bf16x8, pw_); \
        _Pragma("unroll") for (int et = 0; et < 8; ++et) { const bf16x8 vf_ = tr_frag16p(lds + (BUF) * NA_TBYTES, NA_TSTRIDE, kc0, 16 * et, lane); \
            O[et] = __builtin_amdgcn_mfma_f32_16x16x32_bf16(vf_, pf_, O[et], 0, 0, 0); } } while (0)
#pragma unroll
    for (int j = 0; j < 9; ++j) {
        if (j < nrows) {
            *(LAS v4u*)(wdst + (j & 1) * NA_TBYTES) = sq[j % NA_PF][0]; *(LAS v4u*)(wdst + (j & 1) * NA_TBYTES + 32 * NA_TSTRIDE) = sq[j % NA_PF][1];
            if (j + NA_PF < nrows) { sq[j % NA_PF][0] = *(const v4u*)(vst + (size_t)((j + NA_PF) * 64) * NPJ); sq[j % NA_PF][1] = *(const v4u*)(vst + (size_t)((j + NA_PF) * 64 + 32) * NPJ); }
            asm volatile("s_waitcnt lgkmcnt(0)" ::: "memory"); __builtin_amdgcn_s_barrier(); asm volatile("" ::: "memory");
            if (shift == 0) { if (j < 8) NA_VROW(j, j & 1); }
            else { if (j >= 1) NA_VROW(j - 1, j & 1); }
        }
    }
#undef NA_VROW
    const float rl = 1.0f / sum;
    bf16* op = (bf16*)(P.ws + WS_XN) + qrow * D + 512 + head * 128 + 4 * g;
#pragma unroll
    for (int et = 0; et < 8; ++et) { const f32x4 y = O[et] * rl; *(v2u*)(op + 16 * et) = (v2u){pk2(y[0], y[1]), pk2(y[2], y[3])}; }
    __syncthreads();
}

__device__ __forceinline__ void gate_unit(const Params& P, int l, int item, LAS unsigned char* lds, const unsigned* rowsq, int wv) {
    const int tid = tid_fresh(wv), lane = tid & 63, wave = tid >> 6, g = lane >> 4, li = lane & 15, rt = wave & 3, kh = wave >> 2;
    const bf16* A = (const bf16*)(P.ws + WS_XN) + (size_t)(item * 64 + rt * 16 + li) * D + kh * 1024 + 8 * g;
    const bf16* B = (const bf16*)(P.ws + WS_WIN) + (size_t)(NPJ + li) * D + kh * 1024 + 8 * g;
    f32x4 acc = {0.f, 0.f, 0.f, 0.f};
#pragma unroll 1
    for (int k0 = 0; k0 < 32; k0 += 8) {
        bf16x8 a[8], b[8];
#pragma unroll
        for (int i = 0; i < 8; ++i) { a[i] = *(const bf16x8*)(A + 32 * (k0 + i)); b[i] = *(const bf16x8*)(B + 32 * (k0 + i)); }
#pragma unroll
        for (int i = 0; i < 8; ++i) acc = __builtin_amdgcn_mfma_f32_16x16x32_bf16(a[i], b[i], acc, 0, 0, 0);
    }
    LAS f32x4* xb = (LAS f32x4*)lds + rt * 64 + lane;
    if (kh == 1) *xb = acc;
    __syncthreads();
    if (kh == 0) { const f32x4 o = *xb; float* gp = (float*)(P.ws + WS_GATES) + (size_t)(item * 64 + rt * 16 + 4 * g) * 16 + li;
#pragma unroll
        for (int j = 0; j < 4; ++j) { const float rs = rsqrtf((float)rowsq[item * 64 + rt * 16 + 4 * g + j] * (1.0f / (2048.0f * 4096.0f)) + 1e-6f); gp[j * 16] = (acc[j] + o[j]) * rs; } }
    __syncthreads();
}
__device__ __forceinline__ void scan_phase(const Params& P, int l, int wv) {
    const int gt = blockIdx.x * 512 + tid_fresh(wv), GT = GRID * 512;
    const bf16* cl = (const bf16*)(P.ws + WS_CLOC); bf16* cs = (bf16*)(P.ws + WS_CST);
    const float* mloc = (const float*)(P.ws + WS_MLOC); const float* gtot = (const float*)(P.ws + WS_GTOT);
#pragma unroll 1
    for (int v = gt; v < 128 * 4096 + 64 * 32; v += GT) {
        const bool isn = v >= 128 * 4096;
        const int chain = isn ? (v - 128 * 4096) >> 5 : v >> 12, e4 = isn ? (v - 128 * 4096) & 31 : v & 4095;
        const int typ = chain >> 6, dir = chain & 1, h = (chain >> 1) & 3;
        float dec_r = 0.f; if (typ) dec_r = __builtin_amdgcn_exp2f(128.f * ret_log2g(P, l, dir, h));
        float zz = 0.f; asm volatile("" : "+v"(zz));
        f32x4 st = {zz, zz, zz, zz}; float m = NEGF;
        f32x4 lcv[16];
#pragma unroll
        for (int k = 0; k < 16; ++k) { const int oc = dir ? 15 - k : k; const size_t idx = (size_t)chain * 16 + oc;
            if (isn) lcv[k] = *(const f32x4*)((const float*)(P.ws + WS_NLOC) + idx * 128 + 4 * e4);
            else { const v2u w = *(const v2u*)(cl + idx * 16384 + 4 * e4); lcv[k] = (f32x4){lo2f(w.x), hi2f(w.x), lo2f(w.y), hi2f(w.y)}; } }
#pragma unroll
        for (int k = 0; k < 16; ++k) {
            const int oc = dir ? 15 - k : k; const size_t idx = (size_t)chain * 16 + oc;
            float dec, scl;
            if (typ) { dec = dec_r; scl = 1.f; }
            else { const float gg = gtot[idx], ml = mloc[idx], mn = fmaxf(gg + m, ml); dec = exp_f(gg + m - mn); scl = exp_f(ml - mn);
                if (isn && e4 == 0) ((float*)(P.ws + WS_MST))[idx] = m;
                m = mn; }
            if (isn) { float* ns = (float*)(P.ws + WS_NST) + idx * 128 + 4 * e4; *(f32x4*)ns = st; }
            else { *(v2u*)(cs + idx * 16384 + 4 * e4) = (v2u){pk2(st.x, st.y), pk2(st.z, st.w)}; }
            st = st * dec + lcv[k] * scl;
        }
    }
}
typedef __attribute__((address_space(1))) unsigned gu32;
#define XB_TMO      128
#define XB_XCNT(j)  (256  + 64 * (j))
#define XB_XSUB(j)  (1280 + 64 * (j))
#define XB_XGEN(j)  (2304 + 64 * (j))
#define XB_TOP      3328
#define XB_TOPGEN   3392
#define XCD_BAR_WORDS 3456
#define XB_SPIN_CAP (1u << 18)

__device__ __forceinline__ unsigned xb_ld(unsigned* p)              { return __hip_atomic_load(p, __ATOMIC_RELAXED, __HIP_MEMORY_SCOPE_AGENT); }
__device__ __forceinline__ unsigned xb_add(unsigned* p, unsigned v) { return __hip_atomic_fetch_add(p, v, __ATOMIC_RELAXED, __HIP_MEMORY_SCOPE_AGENT); }
__device__ __forceinline__ unsigned xb_xcc_id() { return (unsigned)__builtin_amdgcn_s_getreg((3 << 11) | 20) & 0xFu; }
#define XB_SPIN(cond, bar) do { unsigned _sp = 0; while (cond) { __builtin_amdgcn_s_sleep(1); \
    if ((++_sp & 255u) == 0u) { if (xb_ld(&(bar)[XB_TMO])) break; if (_sp > XB_SPIN_CAP) { atomicAdd(&(bar)[XB_TMO], 1u); break; } } } } while (0)

struct XcdBarrier {
    unsigned* bar; unsigned x;
    volatile LAS unsigned* st;
};

__device__ __forceinline__ XcdBarrier xcd_barrier_post(unsigned* bar, volatile LAS unsigned* st, int wv) {
    XcdBarrier b; b.bar = bar; b.x = xb_xcc_id(); b.st = st;
    if (wv == 0 && __builtin_amdgcn_mbcnt_hi(~0u, __builtin_amdgcn_mbcnt_lo(~0u, 0u)) == 0u) (void)xb_add(&bar[XB_XCNT(b.x)], 1u);
    return b;
}
__device__ __forceinline__ void xcd_barrier_complete(unsigned* bar, unsigned x, unsigned& nloc, unsigned& nx) {
    const unsigned G = gridDim.x * gridDim.y * gridDim.z;
    unsigned sum, cnt, mine, sp = 0u;
    for (;;) {
        sum = 0u; cnt = 0u; mine = 0u;
#pragma unroll
        for (unsigned j = 0; j < 16; ++j) { const unsigned c = xb_ld(&bar[XB_XCNT(j)]); sum += c; cnt += (c > 0u) ? 1u : 0u; mine = (j == x) ? c : mine; }
        if (sum == G) break;
        __builtin_amdgcn_s_sleep(1);
        if ((++sp & 255u) == 0u) { if (xb_ld(&bar[XB_TMO])) break; if (sp > XB_SPIN_CAP) { atomicAdd(&bar[XB_TMO], 1u); break; } }
    }
    nloc = mine > 0u ? mine : 1u; nx = cnt > 0u ? cnt : 1u;
}

__device__ __forceinline__ void xcd_barrier(const XcdBarrier& b, int wv) {
    asm volatile("s_waitcnt vmcnt(0)" ::: "memory");
    __syncthreads();
    if (wv == 0 && __builtin_amdgcn_mbcnt_hi(~0u, __builtin_amdgcn_mbcnt_lo(~0u, 0u)) == 0u) {
        unsigned* bar = b.bar;
        __builtin_amdgcn_s_waitcnt(0);
        unsigned nloc = b.st[0], nx = b.st[1];
        if (nloc == 0u) { xcd_barrier_complete(bar, b.x, nloc, nx); b.st[0] = nloc; b.st[1] = nx; }
        const unsigned old = xb_add(&bar[XB_XSUB(b.x)], 1u);
        const unsigned gen = old / nloc;
        if (old + 1u == (gen + 1u) * nloc) {
            __builtin_amdgcn_fence(__ATOMIC_RELEASE, "agent");
            asm volatile("s_waitcnt vmcnt(0)" ::: "memory");
            const unsigned og = xb_add(&bar[XB_TOP], 1u);
            const unsigned tg = og / nx;
            if (og + 1u == (tg + 1u) * nx) xb_add(&bar[XB_TOPGEN], 1u);
            else XB_SPIN(xb_ld(&bar[XB_TOPGEN]) == tg, bar);
            __builtin_amdgcn_fence(__ATOMIC_ACQUIRE, "agent");
            xb_add(&bar[XB_XGEN(b.x)], 1u);
            asm volatile("s_waitcnt vmcnt(0)" ::: "memory");
        } else {
            XB_SPIN(xb_ld(&bar[XB_XGEN(b.x)]) == gen, bar);
            __builtin_amdgcn_fence(__ATOMIC_ACQUIRE, "agent");
            asm volatile("s_waitcnt vmcnt(0)" ::: "memory");
        }
    }
    __syncthreads();
}
__global__ void __launch_bounds__(512, 2) fwd_kernel(Params P) {
    extern __shared__ __attribute__((aligned(16))) unsigned char lds_raw[];
    LAS unsigned char* lds = (LAS unsigned char*)lds_raw;
    cg::grid_group grid = cg::this_grid();
    const int wv = __builtin_amdgcn_readfirstlane(threadIdx.x >> 6);
    { volatile LAS unsigned* misc = (volatile LAS unsigned*)(lds + MISC_OFF); if (threadIdx.x < 32) misc[threadIdx.x] = 0u;
      if (blockIdx.x == 0) for (int i = threadIdx.x; i < 4096; i += 512) ((unsigned*)P.ws)[i] = 0u; }
    __syncthreads();
    grid.sync();
    const XcdBarrier bar = xcd_barrier_post((unsigned*)P.ws, (volatile LAS unsigned*)(lds + MISC_OFF) + 8, wv);
#define GRID_SYNC() xcd_barrier(bar, wv)
    const int G = GRID, bid = blockIdx.x;
    bf16* xn = (bf16*)(P.ws + WS_XN); bf16* proj = (bf16*)(P.ws + WS_PROJ); bf16* hidden = proj;
    bf16* wgu = (bf16*)(P.ws + WS_WGU); bf16* wdn = (bf16*)(P.ws + WS_WDN); bf16* win = (bf16*)(P.ws + WS_WIN); bf16* wout = (bf16*)(P.ws + WS_WOUT);
    bf16* xnb = (bf16*)(P.ws + WS_CLOC);
    unsigned* rowsq = (unsigned*)(P.ws + WS_ROWSQ);
#pragma unroll 1
    for (int l = 0; l < 2; ++l) {
#if !defined(PH) || (PH & 1)
        convert_weights(P, l, lds, wv);
#endif
        if (l == 0) {
            cast_rows_bf16(P.in[I_X], xn, rowsq, wv);
            unsigned zlo = 0u; asm volatile("" : "+v"(zlo));
#pragma unroll 1
            for (int i = bid * 512 + tid_fresh(wv); i < 8 * M; i += G * 512) __hip_atomic_store(rowsq + M + i, zlo, __ATOMIC_RELAXED, __HIP_MEMORY_SCOPE_AGENT);
        }
        GRID_SYNC();
#pragma unroll 1
        for (int f = 0; f < 2; ++f) {
            if (f == 1) {
#if !defined(PH) || (PH & 128)
                gate_unit(P, l, bid, lds, rowsq + (size_t)(4 * l + 1) * M, wv);
                { pg8::Gemm g{xn, win, M, NPJ, D}; pg8::StaticOrder S; S.init(M, NPJ, G, bid, 4); pg8::EpiProj E{proj, NPJ, rowsq + (size_t)(4 * l + 1) * M};
                  pg8::gemm_phase<pg8::EpiProj, pg8::StaticOrder, true, true>(lds, g, S, E, wv); }
#endif
                GRID_SYNC();
                prep_phase(P, l, wv);
#pragma unroll 1
                for (int u = (bid & 7) * 32 + (bid >> 3); u < 1024; u += G) {
#if !defined(PH) || (PH & 8)
                    na_block_unit(P, l, u, lds, wv);
#endif
                }
                GRID_SYNC();
#pragma unroll 1
                for (int k4 = 0; k4 < 4; ++k4) { const int u = (k4 >> 1) * 512 + (bid & 7) * 64 + (bid >> 3) + 32 * (k4 & 1);
#if !defined(PH) || (PH & 2)
                    if (u < 512) lin_local_unit<false>(P, l, u >> 6, (u >> 4) & 3, u & 15, lds, wv);
#endif
#if !defined(PH) || (PH & 4)
                    if (u >= 512) lin_local_unit<true>(P, l, (u - 512) >> 6, (u >> 4) & 3, u & 15, lds, wv);
#endif
                }
                GRID_SYNC();
#if !defined(PH) || (PH & 16)
                scan_phase(P, l, wv);
#endif
                GRID_SYNC();
#pragma unroll 1
                for (int k4 = 0; k4 < 4; ++k4) { const int u = (k4 >> 1) * 512 + (bid & 7) * 64 + (bid >> 3) + 32 * (k4 & 1);
#if !defined(PH) || (PH & 32)
                    if (u < 512) lin_out_unit<false>(P, l, u >> 6, (u >> 4) & 3, u & 15, lds, wv);
#endif
#if !defined(PH) || (PH & 64)
                    if (u >= 512) lin_out_unit<true>(P, l, (u - 512) >> 6, (u >> 4) & 3, u & 15, lds, wv);
#endif
                }
                GRID_SYNC();
#if !defined(PH) || (PH & 256)
                { pg8::Gemm g{xn, wout, M, D, D}; pg8::StaticOrder S; S.init(M, D, G, bid, 4); pg8::EpiResid E{P.out, P.out, xnb, rowsq + (size_t)(4 * l + 2) * M, D, 1.0f};
                  pg8::gemm_phase<pg8::EpiResid, pg8::StaticOrder, true, true>(lds, g, S, E, wv); }
#endif
                GRID_SYNC();
            }
#if !defined(PH) || (PH & 512)
            { pg8::Gemm g{f ? xnb : xn, wgu + (size_t)f * NGU * D, M, NGU, D}; pg8::StaticOrder S; S.init(M, NGU, G, bid, 4); pg8::EpiSwiGLU E{hidden, FF, rowsq + (size_t)(4 * l + 2 * f) * M};
              pg8::gemm_phase<pg8::EpiSwiGLU, pg8::StaticOrder, true, true>(lds, g, S, E, wv); }
#endif
            GRID_SYNC();
#if !defined(PH) || (PH & 1024)
            { pg8::Gemm g{hidden, wdn + (size_t)f * D * FF, M, D, FF}; pg8::StaticOrder S; S.init(M, D, G, bid, 4, 1);
              pg8::EpiResid E{(l == 0 && f == 0) ? P.in[I_X] : P.out, P.out, xn, rowsq + (size_t)(4 * l + (f ? 4 : 1)) * M, D, 0.5f};
              pg8::gemm_phase<pg8::EpiResid, pg8::StaticOrder, true, true>(lds, g, S, E, wv); }
#endif
            GRID_SYNC();
        }
    }
    rms_rows_f32(P.out, P.in[I_FINN], P.out, wv);
}

extern "C" void kernel_launch(void* const* d_in, const int* in_sizes, int n_in, void* d_out, int out_size, void* d_ws, size_t ws_size, hipStream_t stream) {
    static int grid = 0;
    if (grid == 0) {
        if (n_in != 18 || in_sizes[0] != M * D || out_size != M * D || ws_size < WS_END) {
            fprintf(stderr, "kernel_launch: unexpected shapes: n_in %d in0 %d out %d ws %zu (need %zu)\n", n_in, n_in > 0 ? in_sizes[0] : -1, out_size, ws_size, (size_t)WS_END); grid = -1; return; }
        int dev = 0, cus = 0, per_cu = 0;
        (void)hipGetDevice(&dev); (void)hipDeviceGetAttribute(&cus, hipDeviceAttributeMultiprocessorCount, dev);
        (void)hipFuncSetAttribute((const void*)fwd_kernel, hipFuncAttributeMaxDynamicSharedMemorySize, LDS_BYTES);
        (void)hipOccupancyMaxActiveBlocksPerMultiprocessor(&per_cu, (const void*)fwd_kernel, 512, LDS_BYTES);
        if (per_cu < 1) per_cu = 1;
        grid = cus * per_cu;
        if (grid < GRID) { fprintf(stderr, "kernel_launch: this kernel needs %d co-resident workgroups, the device holds %d\n", GRID, grid); grid = -1; return; }
        grid = GRID;
        fprintf(stderr, "kernel_launch: grid %d (cus %d x %d), ws %zu\n", grid, cus, per_cu, ws_size);
    }
    if (grid < 0) return;
    Params p{};
    for (int i = 0; i < 18; ++i) p.in[i] = (const float*)d_in[i];
    p.out = (float*)d_out; p.ws = (unsigned char*)d_ws;
    void* args[] = {&p};
    hipError_t e = hipLaunchCooperativeKernel((const void*)fwd_kernel, dim3(grid), dim3(512), args, LDS_BYTES, stream);
    if (e != hipSuccess) fprintf(stderr, "kernel_launch: cooperative launch failed: %s (grid %d)\n", hipGetErrorString(e), grid);
}
```

```cpp
#include <hip/hip_runtime.h>
#include <hip/hip_cooperative_groups.h>
#include <cstdio>
#include <cstdint>
namespace cg = cooperative_groups;
__device__ __forceinline__ int tid_fresh(int wv) { int t; asm volatile("v_mbcnt_lo_u32_b32 %0, -1, 0\n\tv_mbcnt_hi_u32_b32 %0, -1, %0" : "=v"(t)); return wv * 64 + t; }
namespace pg8 {
#define PG8_LAS __attribute__((address_space(3)))
typedef unsigned short bf16_t;
typedef short bf16x8 __attribute__((ext_vector_type(8)));
typedef float f32x4 __attribute__((ext_vector_type(4)));
typedef unsigned u32x4 __attribute__((ext_vector_type(4)));
constexpr int BM = 256, BK = 64, HALF = 128, HTB = HALF * BK * 2  , STAGE_BYTES = 8 * HTB, NXCD = 8, WGM = 8;

__host__ __device__ __forceinline__ int lds_byte(int r, int c) { const int st = (r >> 4) * 2 + (c >> 5), rr = r & 15, cc = c & 31, ob = rr * 64 + cc * 2; return st * 1024 + (ob ^ (((ob >> 9) & 1) << 5)); }
__host__ __device__ __forceinline__ void stage_rc(int b, int& R, int& C) { const int st = b / 1024, sb = b % 1024, swz = sb ^ (((sb >> 9) & 1) << 5); R = (st >> 1) * 16 + swz / 64; C = (st & 1) * 32 + (swz % 64) / 2; }
__host__ __device__ __forceinline__ int perm32(int rho) { const int n = rho >> 4, i = rho & 15; return 8 * (i >> 2) + 4 * n + (i & 3); }

struct Unit { int pm, pn; };
struct Gemm { const bf16_t* A; const bf16_t* Bt; int M, N, K; };

struct StaticOrder {
    int nM, nN, nwg, G, c, wgm, flip;
    __host__ __device__ void init(int M, int N, int G_, int c_, int wgm_ = WGM, int flip_ = 0) { nM = M / BM; nN = N / BM; nwg = nM * nN; G = G_; c = c_; wgm = wgm_; flip = flip_; }
    __host__ __device__ bool next(int i, Unit& u) const {
        const int R = (nwg + G - 1) / G; if (i >= R) return false; const long L = (long)(flip ? R - 1 - i : i) * G + c; if (L >= nwg) return false;
        int wgid = (int)L; { const int q = nwg / NXCD, r = nwg % NXCD, xcd = wgid % NXCD, off = wgid / NXCD; wgid = (xcd < r ? xcd * (q + 1) : r * (q + 1) + (xcd - r) * q) + off; }
        const int nig = wgm * nN, gid = wgid / nig, fm = gid * wgm, gsz = (nM - fm) < wgm ? (nM - fm) : wgm;
        u.pm = fm + ((wgid % nig) % gsz); u.pn = (wgid % nig) / gsz; return true;
    }
    __device__ __forceinline__ void a_ready(const Unit&) const {}
    __device__ __forceinline__ void done(const Unit&) const {}
};

typedef float f32x2 __attribute__((ext_vector_type(2))); typedef __bf16 bf16x2_t __attribute__((ext_vector_type(2)));
__device__ __forceinline__ unsigned cvt_pk_bf16(float lo, float hi) { f32x2 v = {lo, hi}; bf16x2_t b = __builtin_convertvector(v, bf16x2_t); return __builtin_bit_cast(unsigned, b); }
__device__ __forceinline__ float silu_f(float x) { return x * __builtin_amdgcn_rcpf(1.0f + __builtin_amdgcn_exp2f(-1.4426950408889634f * x)); }
struct EpiSwiGLU {
    static constexpr bool PERM = true, AFTER_DRAIN = false;
    struct Pre {};
    __device__ __forceinline__ Pre prefetch(const Unit&, int, int) const { return Pre{}; }
    bf16_t* O; int ldc; const __attribute__((address_space(3))) float* rstab;
    __device__ __forceinline__ void operator()(const f32x4 (&acc)[2][2][4][2], const Unit& u, int wr, int wc, int fr, int fq, const Pre& pre) const {
        const int row0 = u.pm * BM + wr * 64 + fr, col0 = u.pn * HALF + wc * 32 + 8 * fq;
        float rs[2][4];
#pragma unroll
        for (int ai = 0; ai < 2; ++ai)
#pragma unroll
            for (int m = 0; m < 4; ++m) rs[ai][m] = rstab[(u.pm & 7) * BM + wr * 64 + fr + ai * HALF + m * 16];
#pragma unroll
        for (int ai = 0; ai < 2; ++ai)
#pragma unroll
            for (int m = 0; m < 4; ++m) { bf16_t* rowp = O + (size_t)(row0 + ai * HALF + m * 16) * ldc + col0;
                const f32x4 g0 = acc[ai][0][m][0] * rs[ai][m], g1 = acc[ai][0][m][1] * rs[ai][m], u0 = acc[ai][1][m][0] * rs[ai][m], u1 = acc[ai][1][m][1] * rs[ai][m];
                u32x4 w; w.x = cvt_pk_bf16(silu_f(g0[0]) * u0[0], silu_f(g0[1]) * u0[1]); w.y = cvt_pk_bf16(silu_f(g0[2]) * u0[2], silu_f(g0[3]) * u0[3]);
                w.z = cvt_pk_bf16(silu_f(g1[0]) * u1[0], silu_f(g1[1]) * u1[1]); w.w = cvt_pk_bf16(silu_f(g1[2]) * u1[2], silu_f(g1[3]) * u1[3]);
                *(u32x4*)rowp = w; }
    }
};
struct EpiResid {
    static constexpr bool PERM = false, AFTER_DRAIN = false;
    struct Pre {};
    __device__ __forceinline__ Pre prefetch(const Unit&, int, int) const { return Pre{}; }
    const float* base; float* out; bf16_t* hb; unsigned* rowsq; int ldc; float scale;
    __device__ __forceinline__ void operator()(const f32x4 (&acc)[2][2][4][2], const Unit& u, int wr, int wc, int fr, int fq, const Pre&) const {
        typedef unsigned u32x2 __attribute__((ext_vector_type(2)));
        const int row0 = u.pm * BM + wr * 64 + fr, col0 = u.pn * BM + wc * 32 + 4 * fq;
        float ssv[2][4];
#pragma unroll
        for (int ai = 0; ai < 2; ++ai) {
            f32x4 bs[4][2][2];
#pragma unroll
            for (int m = 0; m < 4; ++m) { const unsigned off = (unsigned)(row0 + ai * HALF + m * 16) * (unsigned)ldc + (unsigned)col0;
#pragma unroll
                for (int bj = 0; bj < 2; ++bj)
#pragma unroll
                    for (int n = 0; n < 2; ++n) bs[m][bj][n] = *(const f32x4*)(base + off + bj * HALF + n * 16); }
            asm volatile("" ::: "memory");
#pragma unroll
            for (int m = 0; m < 4; ++m) { const unsigned off = (unsigned)(row0 + ai * HALF + m * 16) * (unsigned)ldc + (unsigned)col0; float ss = 0.f;
#pragma unroll
                for (int bj = 0; bj < 2; ++bj)
#pragma unroll
                    for (int n = 0; n < 2; ++n) { const f32x4 v = bs[m][bj][n] + acc[ai][bj][m][n] * scale;
                        *(f32x4*)(out + off + bj * HALF + n * 16) = v; *(u32x2*)(hb + off + bj * HALF + n * 16) = (u32x2){cvt_pk_bf16(v[0], v[1]), cvt_pk_bf16(v[2], v[3])};
                        ss += (v[0] * v[0] + v[1] * v[1]) + (v[2] * v[2] + v[3] * v[3]); }
                ssv[ai][m] = ss; }
            asm volatile("" ::: "memory");
        }
#pragma unroll
        for (int ai = 0; ai < 2; ++ai)
#pragma unroll
            for (int m = 0; m < 4; ++m) { float ss = ssv[ai][m]; ss += __shfl_xor(ss, 16); ss += __shfl_xor(ss, 32);
                if (fq == 0) (void)__hip_atomic_fetch_add(rowsq + row0 + ai * HALF + m * 16, (unsigned)(ss * 4096.0f + 0.5f), __ATOMIC_RELAXED, __HIP_MEMORY_SCOPE_AGENT); }
    }
};
struct EpiProj {
    static constexpr bool PERM = true, AFTER_DRAIN = false;
    struct Pre {};
    __device__ __forceinline__ Pre prefetch(const Unit&, int, int) const { return Pre{}; }
    bf16_t* O; int ldc; const __attribute__((address_space(3))) float* rstab;
    __device__ __forceinline__ void operator()(const f32x4 (&acc)[2][2][4][2], const Unit& u, int wr, int wc, int fr, int fq, const Pre& pre) const {
        const int row0 = u.pm * BM + wr * 64 + fr, col0 = u.pn * BM + wc * 32 + 8 * fq;
#pragma unroll
        for (int ai = 0; ai < 2; ++ai)
#pragma unroll
            for (int m = 0; m < 4; ++m) { bf16_t* rowp = O + (size_t)(row0 + ai * HALF + m * 16) * ldc + col0;
                const float rs = rstab[(u.pm & 7) * BM + wr * 64 + fr + ai * HALF + m * 16];
#pragma unroll
                for (int bj = 0; bj < 2; ++bj) { const f32x4 v0 = acc[ai][bj][m][0] * rs, v1 = acc[ai][bj][m][1] * rs;
                    u32x4 w; w.x = cvt_pk_bf16(v0[0], v0[1]); w.y = cvt_pk_bf16(v0[2], v0[3]); w.z = cvt_pk_bf16(v1[0], v1[1]); w.w = cvt_pk_bf16(v1[2], v1[3]);
                    *(u32x4*)(rowp + bj * HALF) = w; } }
    }
};
template <class Epi, class Sched, bool ALIGN_EPI = false, bool SP2 = false>
__device__ __forceinline__ void gemm_phase(PG8_LAS unsigned char* lds, const Gemm g, const Sched S, const Epi E, int wv) {
    const int tid = tid_fresh(wv), wid = __builtin_amdgcn_readfirstlane(tid >> 6), lane = tid & 63, wr = wid >> 2, wc = wid & 3, fr = lane & 15, fq = lane >> 4;
    const int K = g.K, nt = K / BK;
    unsigned voffA[2], voffB[2];
#pragma unroll
    for (int i = 0; i < 2; ++i) { int R, C; stage_rc(tid * 16 + i * 8192, R, C); const int Rb = Epi::PERM ? ((R & ~31) + perm32(R & 31)) : R;
        voffA[i] = (unsigned)(R * K + C) * 2u; voffB[i] = (unsigned)(Rb * K + C) * 2u; }
    const size_t kstep = (size_t)(BK * 2);
    const size_t hstep = (size_t)HALF * K * 2;
    const size_t tstep = 2 * hstep;
    const unsigned ldsw = (unsigned)wid * 1024u;
    const int aoff = lds_byte(wr * 64 + fr, fq * 8), boff = lds_byte(wc * 32 + fr, fq * 8);
#define PG8_SA(b, h) (((b) * 2 + (h)) * HTB)
#define PG8_SB(b, h) ((4 + (b) * 2 + (h)) * HTB)
#define PG8_STAGE(bufoff, gbase, voff) do { _Pragma("unroll") for (int _i = 0; _i < 2; ++_i) \
        __builtin_amdgcn_global_load_lds((const unsigned*)((const char*)(gbase) + (voff)[_i]), (PG8_LAS unsigned*)(lds + (bufoff) + ldsw + _i * 8192), 16, 0, 0); } while (0)
#define PG8_LDA(dst, b, h) do { _Pragma("unroll") for (int m = 0; m < 4; ++m) _Pragma("unroll") for (int k = 0; k < 2; ++k) dst[m][k] = *(const PG8_LAS bf16x8*)(lds + PG8_SA(b, h) + aoff + m * 2048 + k * 1024); } while (0)
#define PG8_LDB(dst, b, h) do { _Pragma("unroll") for (int n = 0; n < 2; ++n) _Pragma("unroll") for (int k = 0; k < 2; ++k) dst[n][k] = *(const PG8_LAS bf16x8*)(lds + PG8_SB(b, h) + boff + n * 2048 + k * 1024); } while (0)
#define PG8_MMA(ai, bj, At, Bt) do { __builtin_amdgcn_s_setprio(1); _Pragma("unroll") for (int m = 0; m < 4; ++m) _Pragma("unroll") for (int n = 0; n < 2; ++n) _Pragma("unroll") for (int k = 0; k < 2; ++k) \
        acc[ai][bj][m][n] = __builtin_amdgcn_mfma_f32_16x16x32_bf16(Bt[n][k], At[m][k], acc[ai][bj][m][n], 0, 0, 0); __builtin_amdgcn_s_setprio(0); } while (0)
#define PG8_WAIT_V(n) asm volatile("s_waitcnt vmcnt(" #n ")" ::: "memory")
#define PG8_WAIT_L(n) asm volatile("s_waitcnt lgkmcnt(" #n ")" ::: "memory")
#define PG8_BAR __builtin_amdgcn_s_barrier()
#define PG8_SCHED __builtin_amdgcn_sched_barrier(0)
    Unit cur, nxt; int ui = 0;
    if (!S.next(0, cur)) return;
    f32x4 acc[2][2][4][2];
#pragma unroll
    for (int a = 0; a < 2; ++a)
#pragma unroll
        for (int b = 0; b < 2; ++b)
#pragma unroll
            for (int m = 0; m < 4; ++m)
#pragma unroll
                for (int n = 0; n < 2; ++n) acc[a][b][m][n] = (f32x4){0.f, 0.f, 0.f, 0.f};
    bf16x8 At[4][2], B0[2][2], B1[2][2];
    const char* cA = (const char*)g.A + (size_t)cur.pm * tstep; const char* cB = (const char*)g.Bt + (size_t)cur.pn * tstep;
    S.a_ready(cur);
    typename Epi::Pre pre = E.prefetch(cur, wr, fr);
    if constexpr (SP2) {
        PG8_STAGE(PG8_SB(0, 0), cB, voffB); PG8_STAGE(PG8_SB(0, 1), cB + hstep, voffB); PG8_STAGE(PG8_SA(0, 0), cA, voffA); PG8_STAGE(PG8_SA(0, 1), cA + hstep, voffA);
        if (wr == 1) PG8_BAR;
        PG8_WAIT_V(2); PG8_BAR;
        PG8_STAGE(PG8_SB(1, 0), cB + kstep, voffB); PG8_STAGE(PG8_SA(1, 0), cA + kstep, voffA); PG8_STAGE(PG8_SB(1, 1), cB + hstep + kstep, voffB);
        PG8_WAIT_V(6); PG8_BAR;
    } else {
        PG8_STAGE(PG8_SB(0, 0), cB, voffB); PG8_STAGE(PG8_SA(0, 0), cA, voffA); PG8_STAGE(PG8_SB(0, 1), cB + hstep, voffB); PG8_STAGE(PG8_SA(0, 1), cA + hstep, voffA);
        if (wr == 1) PG8_BAR;
        PG8_WAIT_V(4); PG8_BAR;
        PG8_STAGE(PG8_SB(1, 0), cB + kstep, voffB); PG8_STAGE(PG8_SA(1, 0), cA + kstep, voffA); PG8_STAGE(PG8_SB(1, 1), cB + hstep + kstep, voffB);
        PG8_WAIT_V(6); PG8_BAR;
    }
    for (;;) {
        const bool has_next = S.next(ui + 1, nxt);
        const char* nA = has_next ? (const char*)g.A + (size_t)nxt.pm * tstep : cA; const char* nB = has_next ? (const char*)g.Bt + (size_t)nxt.pn * tstep : cB;
        for (int t = 0; t < nt; t += 2) {
            const bool last = (t == nt - 2);
            const char* a1 = cA + (size_t)(t + 1) * kstep;
            const char* a2 = last ? nA : cA + (size_t)(t + 2) * kstep; const char* b2 = last ? nB : cB + (size_t)(t + 2) * kstep;
            const char* a3 = a2 + kstep; const char* b3 = b2 + kstep;
            if (last && has_next) S.a_ready(nxt);
            if constexpr (SP2) {
            PG8_LDB(B0, 0, 0); PG8_LDB(B1, 0, 1); PG8_SCHED; PG8_LDA(At, 0, 0); PG8_STAGE(PG8_SA(1, 1), a1 + hstep, voffA);
            PG8_WAIT_V(8); PG8_WAIT_L(0); PG8_BAR; PG8_MMA(0, 0, At, B0); PG8_MMA(0, 1, At, B1); PG8_BAR; PG8_SCHED;
            PG8_LDA(At, 0, 1); PG8_STAGE(PG8_SB(0, 0), b2, voffB); PG8_STAGE(PG8_SB(0, 1), b2 + hstep, voffB); PG8_STAGE(PG8_SA(0, 0), a2, voffA);
            PG8_WAIT_V(8); PG8_WAIT_L(0); PG8_BAR; PG8_MMA(1, 0, At, B0); PG8_MMA(1, 1, At, B1); PG8_BAR; PG8_SCHED;
            PG8_LDB(B0, 1, 0); PG8_LDB(B1, 1, 1); PG8_SCHED; PG8_LDA(At, 1, 0); PG8_STAGE(PG8_SA(0, 1), a2 + hstep, voffA);
            PG8_WAIT_V(8); PG8_WAIT_L(0); PG8_BAR; PG8_MMA(0, 0, At, B0); PG8_MMA(0, 1, At, B1); PG8_BAR; PG8_SCHED;
            PG8_LDA(At, 1, 1); PG8_STAGE(PG8_SB(1, 0), b3, voffB); PG8_STAGE(PG8_SB(1, 1), b3 + hstep, voffB); PG8_STAGE(PG8_SA(1, 0), a3, voffA);
            PG8_WAIT_V(8); PG8_WAIT_L(0); PG8_BAR; PG8_MMA(1, 0, At, B0); PG8_MMA(1, 1, At, B1); PG8_BAR; PG8_SCHED;
            } else {
            PG8_LDB(B0, 0, 0); PG8_SCHED; PG8_LDA(At, 0, 0); PG8_STAGE(PG8_SA(1, 1), a1 + hstep, voffA);
            PG8_WAIT_L(8); PG8_BAR; PG8_WAIT_L(0); PG8_MMA(0, 0, At, B0); PG8_BAR; PG8_SCHED;
            PG8_LDB(B1, 0, 1); PG8_STAGE(PG8_SB(0, 0), b2, voffB);
            PG8_BAR; PG8_WAIT_L(0); PG8_MMA(0, 1, At, B1); PG8_BAR;
            PG8_LDA(At, 0, 1); PG8_STAGE(PG8_SA(0, 0), a2, voffA);
            PG8_BAR; PG8_WAIT_L(0); PG8_MMA(1, 0, At, B0); PG8_BAR; PG8_SCHED;
            PG8_STAGE(PG8_SB(0, 1), b2 + hstep, voffB);
            PG8_WAIT_V(6); PG8_BAR; PG8_MMA(1, 1, At, B1); PG8_BAR;
            PG8_LDB(B0, 1, 0); PG8_SCHED; PG8_LDA(At, 1, 0); PG8_STAGE(PG8_SA(0, 1), a2 + hstep, voffA);
            PG8_WAIT_L(8); PG8_BAR; PG8_WAIT_L(0); PG8_MMA(0, 0, At, B0); PG8_BAR; PG8_SCHED;
            PG8_LDB(B1, 1, 1); PG8_STAGE(PG8_SB(1, 0), b3, voffB);
            PG8_BAR; PG8_WAIT_L(0); PG8_MMA(0, 1, At, B1); PG8_BAR;
            PG8_LDA(At, 1, 1); PG8_STAGE(PG8_SA(1, 0), a3, voffA);
            PG8_BAR; PG8_WAIT_L(0); PG8_MMA(1, 0, At, B0); PG8_BAR; PG8_SCHED;
            PG8_STAGE(PG8_SB(1, 1), b3 + hstep, voffB);
            PG8_WAIT_V(6); PG8_BAR; PG8_MMA(1, 1, At, B1); PG8_BAR;
            }
        }
        if constexpr (ALIGN_EPI) { if (wr == 0) PG8_BAR; }
        if constexpr (!Epi::AFTER_DRAIN) { E(acc, cur, wr, wc, fr, fq, pre); S.done(cur); }
        if (!has_next) break;
#pragma unroll
        for (int a = 0; a < 2; ++a)
#pragma unroll
            for (int b = 0; b < 2; ++b)
#pragma unroll
                for (int m = 0; m < 4; ++m)
#pragma unroll
                    for (int n = 0; n < 2; ++n) acc[a][b][m][n] = (f32x4){0.f, 0.f, 0.f, 0.f};
        cur = nxt; cA = nA; cB = nB; ++ui;
        pre = E.prefetch(cur, wr, fr);
        if constexpr (ALIGN_EPI) { if (wr == 1) PG8_BAR; }
    }
    PG8_WAIT_V(0);
    if constexpr (!ALIGN_EPI) { if (wr == 0) PG8_BAR; }
    PG8_BAR;
    if constexpr (Epi::AFTER_DRAIN) { E.fused(acc, cur, wr, wc, fr, fq, lds, wid, lane); S.done(cur); }
#undef PG8_SA
#undef PG8_SB
#undef PG8_STAGE
#undef PG8_LDA
#undef PG8_LDB
#undef PG8_MMA
#undef PG8_WAIT_V
#undef PG8_WAIT_L
#undef PG8_BAR
#undef PG8_SCHED
}
}
#define LAS __attribute__((address_space(3)))
typedef unsigned short bf16;
typedef unsigned v4u __attribute__((ext_vector_type(4)));
typedef unsigned v2u __attribute__((ext_vector_type(2)));
typedef float f32x4 __attribute__((ext_vector_type(4)));
typedef short bf16x8 __attribute__((ext_vector_type(8)));
typedef short s16x4 __attribute__((ext_vector_type(4)));
typedef short v4i16_t __attribute__((ext_vector_type(4)));
typedef float f32x16 __attribute__((ext_vector_type(16)));

constexpr int NB = 8, T = 2048, M = NB * T, D = 2048, FF = 5632, NGU = 2 * FF, NPJ = 7168, NPJ_PAD = 7424, NIN = 7184, NCH = 16;
constexpr int PQ_MQ = 0, PQ_MK = 512, PQ_MV = 1024, PQ_MO = 1536, PQ_NQ = 2048, PQ_NK = 3072, PQ_NV = 4096, PQ_RQ = 5120, PQ_RK = 5632, PQ_RV = 6144, PQ_RG = 6656;
constexpr float EPS = 1e-6f, NEGF = -1e30f, LOG2E = 1.4426950408889634f, QSCALE = 0.08838834764831845f;
constexpr size_t MiB = 1u << 20;
constexpr size_t WS_WGU = 1 * MiB;
constexpr size_t SZ_WGU = (size_t)NGU * D * 2;
constexpr size_t WS_WDN = WS_WGU + 2 * SZ_WGU;
constexpr size_t SZ_WDN = (size_t)D * FF * 2;
constexpr size_t WS_WIN = WS_WDN + 2 * SZ_WDN;
constexpr size_t WS_WOUT = WS_WIN + (size_t)NPJ_PAD * D * 2;
constexpr size_t WS_XN = WS_WOUT + (size_t)D * D * 2;
constexpr size_t WS_PROJ = WS_XN + (size_t)M * D * 2;
constexpr size_t WS_GATES = WS_PROJ + (size_t)M * NPJ * 2;
constexpr size_t WS_CLOC = WS_GATES + (size_t)M * 16 * 4;
constexpr size_t WS_CST = WS_CLOC + (size_t)2048 * 16384 * 4;
constexpr size_t WS_NLOC = WS_CST + (size_t)2048 * 16384 * 2;
constexpr size_t WS_NST = WS_NLOC + (size_t)1024 * 128 * 4;
constexpr size_t WS_MLOC = WS_NST + (size_t)1024 * 128 * 4;
constexpr size_t WS_GTOT = WS_MLOC + 4096;
constexpr size_t WS_MST = WS_GTOT + 4096;
constexpr size_t WS_ROWSQ = WS_MST + 4096;
constexpr size_t WS_MQK = WS_ROWSQ + (size_t)9 * M * 4;
constexpr size_t WS_END = WS_MQK + (size_t)M * 1024 * 2;
static_assert(WS_END < (size_t)690 * MiB, "workspace map");

struct Params { const float* in[18]; float* out; unsigned char* ws; };
enum { I_X = 0, I_F1N, I_F1GU, I_F1DN, I_MIXN, I_WIN, I_CONVW, I_CONVB, I_GATEB, I_MHN, I_RPB, I_DECAY, I_RHN, I_WOUT, I_F2N, I_F2GU, I_F2DN, I_FINN };

constexpr int LDS_BYTES = 148480, MISC_OFF = 147712, GRID = 256;
constexpr int IMG_STRIDE = 288;
constexpr int IMG_BYTES = 128 * IMG_STRIDE;
constexpr int CT_STRIDE = 272, CT_BYTES = 128 * CT_STRIDE;
constexpr int LDS_IMG0 = 0, LDS_IMG1 = IMG_BYTES, LDS_IMG2 = 2 * IMG_BYTES, LDS_CT0 = 2 * IMG_BYTES, LDS_SCAL = 2 * IMG_BYTES + 2 * CT_BYTES;
static_assert(3 * IMG_BYTES <= LDS_SCAL && LDS_SCAL + 1056 * 4 <= MISC_OFF && MISC_OFF + 128 <= LDS_BYTES, "LDS map");

__device__ __forceinline__ float bf2f(unsigned short b) { return __uint_as_float((unsigned)b << 16); }
__device__ __forceinline__ unsigned pk2(float lo, float hi) { return pg8::cvt_pk_bf16(lo, hi); }
__device__ __forceinline__ float lo2f(unsigned w) { return __uint_as_float(w << 16); }
__device__ __forceinline__ float hi2f(unsigned w) { return __uint_as_float(w & 0xffff0000u); }
__device__ __forceinline__ float wave_sum(float v) {
#pragma unroll
    for (int o = 1; o < 64; o <<= 1) v += __shfl_xor(v, o);
    return v;
}
__device__ __forceinline__ float wave_max(float v) {
#pragma unroll
    for (int o = 1; o < 64; o <<= 1) v = fmaxf(v, __shfl_xor(v, o));
    return v;
}
__device__ __forceinline__ float silu_f(float x) { return pg8::silu_f(x); }
__device__ __forceinline__ float sigmoid_f(float x) { return __builtin_amdgcn_rcpf(1.0f + __builtin_amdgcn_exp2f(-LOG2E * x)); }
__device__ __forceinline__ float logsig_f(float x) { return fminf(x, 0.f) - log1pf(expf(-fabsf(x))); }
__device__ __forceinline__ float exp_f(float x) { return __builtin_amdgcn_exp2f(x * LOG2E); }
__device__ __forceinline__ s16x4 tr_read(const LAS unsigned char* p) { return __builtin_bit_cast(s16x4, __builtin_amdgcn_ds_read_tr16_b64_v4i16((LAS v4i16_t*)p)); }
#define LDS_WAIT() asm volatile("s_waitcnt lgkmcnt(0)" ::: "memory")

template <int MAP> __device__ __forceinline__ int map_row(int n) {
    if (MAP == 1) { const int bj = n >= FF ? 1 : 0, j = n - bj * FF; return (j >> 7) * 256 + bj * 128 + (j & 127); }
    if (MAP == 2) { return n < 2048 ? n : (n < 2064 ? NPJ + (n - 2048) : n - 16); }
    return n;
}
template <int MAP> __device__ __forceinline__ void transpose_item(const float* __restrict__ W, int K, int N, bf16* __restrict__ WT, LAS float* scr, int item, int lane, const float* __restrict__ gain) {
    const int nblk = (N + 31) / 32, kb = item / nblk, nb = item - kb * nblk, k0 = 64 * kb, n0 = 32 * nb;
    const int nn = n0 + (lane & 31); const bool ok = nn < N;
    const float* src = W + (size_t)(k0 + (lane >> 5)) * N + (ok ? nn : 0);
#pragma unroll 16
    for (int i = 0; i < 32; ++i) { const float v = src[(size_t)(2 * i) * N]; scr[(2 * i + (lane >> 5)) * 33 + (lane & 31)] = ok ? v : 0.f; }
    LDS_WAIT(); asm volatile("" ::: "memory");
    const int c = lane & 7;
    f32x4 g0 = {1.f, 1.f, 1.f, 1.f}, g1 = {1.f, 1.f, 1.f, 1.f};
    if (gain) { g0 = *(const f32x4*)(gain + k0 + 8 * c); g1 = *(const f32x4*)(gain + k0 + 8 * c + 4); }
#pragma unroll
    for (int j = 0; j < 4; ++j) { const int n = (lane >> 3) + 8 * j; const LAS float* s = scr + (8 * c) * 33 + n;
        v4u o; o.x = pk2(s[0 * 33] * g0.x, s[1 * 33] * g0.y); o.y = pk2(s[2 * 33] * g0.z, s[3 * 33] * g0.w); o.z = pk2(s[4 * 33] * g1.x, s[5 * 33] * g1.y); o.w = pk2(s[6 * 33] * g1.z, s[7 * 33] * g1.w);
        if (n0 + n < N) *(v4u*)(WT + (size_t)map_row<MAP>(n0 + n) * K + k0 + 8 * c) = o; }
    LDS_WAIT(); asm volatile("" ::: "memory");
}
__device__ __forceinline__ void convert_weights(const Params& P, int l, LAS unsigned char* lds, int wv) {
    const int tid = tid_fresh(wv), lane = tid & 63, wave = tid >> 6;
    LAS float* scr = (LAS float*)(lds + wave * 8448);
    const int gw = blockIdx.x * 8 + wave, NGW = GRID * 8;
    bf16* wgu = (bf16*)(P.ws + WS_WGU); bf16* wdn = (bf16*)(P.ws + WS_WDN); bf16* win = (bf16*)(P.ws + WS_WIN); bf16* wout = (bf16*)(P.ws + WS_WOUT);
    constexpr int I_GU = (D / 64) * (NGU / 32), I_DN = (FF / 64) * (D / 32), I_IN = (D / 64) * ((NIN + 31) / 32), I_OUT = (D / 64) * (D / 32);
    constexpr int NITEMS = 2 * I_GU + 2 * I_DN + I_IN + I_OUT;
#pragma unroll 1
    for (int it = gw; it < NITEMS; it += NGW) {
        int r = it;
        if (r < I_GU) { transpose_item<1>(P.in[I_F1GU] + (size_t)l * D * NGU, D, NGU, wgu, scr, r, lane, P.in[I_F1N] + (size_t)l * D); continue; } r -= I_GU;
        if (r < I_GU) { transpose_item<1>(P.in[I_F2GU] + (size_t)l * D * NGU, D, NGU, wgu + (size_t)NGU * D, scr, r, lane, P.in[I_F2N] + (size_t)l * D); continue; } r -= I_GU;
        if (r < I_DN) { transpose_item<0>(P.in[I_F1DN] + (size_t)l * FF * D, FF, D, wdn, scr, r, lane, nullptr); continue; } r -= I_DN;
        if (r < I_DN) { transpose_item<0>(P.in[I_F2DN] + (size_t)l * FF * D, FF, D, wdn + (size_t)D * FF, scr, r, lane, nullptr); continue; } r -= I_DN;
        if (r < I_IN) { transpose_item<2>(P.in[I_WIN] + (size_t)l * D * NIN, D, NIN, win, scr, r, lane, P.in[I_MIXN] + (size_t)l * D); continue; } r -= I_IN;
        transpose_item<0>(P.in[I_WOUT] + (size_t)l * D * D, D, D, wout, scr, r, lane, nullptr);
    }
}
__device__ __forceinline__ void cast_rows_bf16(const float* src, bf16* dst, unsigned* rowsq, int wv) {
    const int tid = tid_fresh(wv), lane = tid & 63, wave = tid >> 6, gw = blockIdx.x * 8 + wave, NGW = GRID * 8;
#pragma unroll 1
    for (int m = gw; m < M; m += NGW) {
        const f32x4* xr = (const f32x4*)(src + (size_t)m * D) + lane;
        f32x4 v[8]; float s = 0.f;
#pragma unroll
        for (int j = 0; j < 8; ++j) { v[j] = xr[64 * j]; s += (v[j].x * v[j].x + v[j].y * v[j].y) + (v[j].z * v[j].z + v[j].w * v[j].w); }
        s = wave_sum(s);
        v2u* o = (v2u*)(dst + (size_t)m * D) + lane;
#pragma unroll
        for (int j = 0; j < 8; ++j) o[64 * j] = (v2u){pk2(v[j].x, v[j].y), pk2(v[j].z, v[j].w)};
        if (lane == 0) rowsq[m] = (unsigned)(s * 4096.0f + 0.5f);
    }
}
__device__ __forceinline__ void rms_rows_f32(const float* src, const float* __restrict__ gain, float* dst, int wv) {
    const int tid = tid_fresh(wv), lane = tid & 63, wave = tid >> 6, gw = blockIdx.x * 8 + wave, NGW = GRID * 8;
    f32x4 gv[8];
#pragma unroll
    for (int j = 0; j < 8; ++j) gv[j] = *(const f32x4*)(gain + 4 * lane + 256 * j);
#pragma unroll 1
    for (int m = gw; m < M; m += NGW) {
        const f32x4* xr = (const f32x4*)(src + (size_t)m * D) + lane;
        f32x4 v[8]; float s = 0.f;
#pragma unroll
        for (int j = 0; j < 8; ++j) { v[j] = xr[64 * j]; s += (v[j].x * v[j].x + v[j].y * v[j].y) + (v[j].z * v[j].z + v[j].w * v[j].w); }
        const float rstd = rsqrtf(wave_sum(s) * (1.f / D) + EPS);
        f32x4* o = (f32x4*)(dst + (size_t)m * D) + lane;
#pragma unroll
        for (int j = 0; j < 8; ++j) o[64 * j] = v[j] * rstd * gv[j];
    }
}
__device__ __forceinline__ size_t st_idx(int typ, int b, int h, int dir, int oc) { return ((((size_t)typ * 8 + b) * 4 + h) * 2 + dir) * 16 + oc; }
__device__ __forceinline__ bf16x8 tr_frag32(const LAS unsigned char* img, int s0, int c0, int lane) {
    const int hh = lane >> 5, grp = (lane >> 4) & 1, q = (lane & 15) >> 2, p = lane & 3;
    const LAS unsigned char* a = img + (s0 + 8 * hh + q) * IMG_STRIDE + (c0 + 16 * grp + 4 * p) * 2;
    const s16x4 lo = tr_read(a), hi = tr_read(a + 4 * IMG_STRIDE);
    return (bf16x8){lo[0], lo[1], lo[2], lo[3], hi[0], hi[1], hi[2], hi[3]};
}
__device__ __forceinline__ bf16x8 tr_frag16p(const LAS unsigned char* img, int stride, int s0, int c0, int lane) {
    const int g = lane >> 4, q = (lane & 15) >> 2, p = lane & 3;
    const LAS unsigned char* a = img + (s0 + 4 * g + q) * stride + (c0 + 4 * p) * 2;
    const s16x4 lo = tr_read(a), hi = tr_read(a + 16 * stride);
    return (bf16x8){lo[0], lo[1], lo[2], lo[3], hi[0], hi[1], hi[2], hi[3]};
}
template <bool REV, bool MAXOP> __device__ __forceinline__ void wave_scan128(const LAS float* in, LAS float* out, int lane) {
    const int i0 = REV ? 127 - 2 * lane : 2 * lane, i1 = REV ? 126 - 2 * lane : 2 * lane + 1;
    const float x0 = in[i0], x1 = in[i1];
    const float pr = MAXOP ? fmaxf(x0, x1) : x0 + x1;
    float s = pr;
#pragma unroll
    for (int o = 1; o < 64; o <<= 1) { const float y = __shfl_up(s, o); if (lane >= o) s = MAXOP ? fmaxf(s, y) : s + y; }
    float ex = __shfl_up(s, 1);
    if (MAXOP) { ex = lane ? ex : NEGF; out[i0] = fmaxf(ex, x0); out[i1] = fmaxf(ex, pr); }
    else { ex = lane ? ex : 0.f; out[i0] = ex + x0; out[i1] = ex + pr; }
}
__device__ __forceinline__ void rope_cs(int pos, int idx, float& c, float& s) {
    const float inv = exp2f(-(float)idx * 0.20762050593046014f);
    float r = (float)pos * inv; r *= 0.15915494309189535f; r -= floorf(r);
    c = __builtin_amdgcn_cosf(r); s = __builtin_amdgcn_sinf(r);
}
enum { S_LIF = 0, S_BF = 128, S_LIB = 256, S_BB = 384, S_T0 = 512, S_T1 = 640, S_PMF = 768, S_PMB = 896, S_RED = 1024 };
__device__ __forceinline__ void mlstm_scalars(const Params& P, int l, int b, int h, int oc, LAS float* sc, int wv) {
    const int tid = tid_fresh(wv), lane = tid & 63, wave = tid >> 6;
    if (tid < 128) {
        const float* g = (const float*)(P.ws + WS_GATES) + (size_t)(b * T + oc * 128 + tid) * 16; const float* gb = P.in[I_GATEB] + l * 16;
        sc[S_LIF + tid] = g[h] + gb[h]; sc[S_T0 + tid] = logsig_f(g[4 + h] + gb[4 + h]);
        sc[S_LIB + tid] = g[8 + h] + gb[8 + h]; sc[S_T1 + tid] = logsig_f(g[12 + h] + gb[12 + h]);
    }
    __syncthreads();
    if (wave == 0) wave_scan128<false, false>(sc + S_T0, sc + S_BF, lane);
    if (wave == 1) wave_scan128<true, false>(sc + S_T1, sc + S_BB, lane);
    __syncthreads();
}
template <bool MAXOP> __device__ __forceinline__ void scan2(float x0, float x1, int lane, float& y0, float& y1) {
    const float pr = MAXOP ? fmaxf(x0, x1) : x0 + x1;
    float s = pr;
#pragma unroll
    for (int o = 1; o < 64; o <<= 1) { const float y = __shfl_up(s, o); if (lane >= o) s = MAXOP ? fmaxf(s, y) : s + y; }
    float ex = __shfl_up(s, 1);
    if (MAXOP) { ex = lane ? ex : NEGF; y0 = fmaxf(ex, x0); y1 = fmaxf(ex, pr); }
    else { ex = lane ? ex : 0.f; y0 = ex + x0; y1 = ex + pr; }
}
template <bool REV, int MODE> __device__ __forceinline__ void wave_gate_scalars(const Params& P, int l, int b, int h, int oc, LAS float* sc, int lane, int wofs, int bofs, int pofs, size_t sidx) {
    const int i0 = REV ? 127 - 2 * lane : 2 * lane, i1 = REV ? 126 - 2 * lane : 2 * lane + 1;
    const float* g = (const float*)(P.ws + WS_GATES) + (size_t)(b * T + oc * 128) * 16; const float* gb = P.in[I_GATEB] + l * 16;
    const int ci = (REV ? 8 : 0) + h, cf = (REV ? 12 : 4) + h;
    const float li0 = g[i0 * 16 + ci] + gb[ci], li1 = g[i1 * 16 + ci] + gb[ci];
    const float lf0 = logsig_f(g[i0 * 16 + cf] + gb[cf]), lf1 = logsig_f(g[i1 * 16 + cf] + gb[cf]);
    float b0, b1; scan2<false>(lf0, lf1, lane, b0, b1);
    if (MODE == 0) {
        const float gtot = __shfl(b1, 63);
        const float a0 = gtot - b0 + li0, a1 = gtot - b1 + li1;
        const float mloc = wave_max(fmaxf(a0, a1));
        sc[wofs + i0] = exp_f(a0 - mloc); sc[wofs + i1] = exp_f(a1 - mloc);
        if (lane == 0) { ((float*)(P.ws + WS_MLOC))[sidx] = mloc; ((float*)(P.ws + WS_GTOT))[sidx] = gtot; }
    } else {
        const float u0 = li0 - b0, u1 = li1 - b1;
        float p0, p1; scan2<true>(u0, u1, lane, p0, p1);
        const float cmax = wave_max(fmaxf(u0, u1));
        sc[bofs + i0] = b0; sc[bofs + i1] = b1; sc[wofs + i0] = exp_f(fmaxf(u0 - cmax, -80.f)); sc[wofs + i1] = exp_f(fmaxf(u1 - cmax, -80.f)); sc[pofs + i0] = p0; sc[pofs + i1] = p1;
        if (lane == 0) sc[S_RED + (REV ? 1 : 0)] = cmax;
    }
}
__device__ __forceinline__ void prep_phase(const Params& P, int l, int wv) {
    const int tid = tid_fresh(wv), lane = tid & 63, wave = tid >> 6, gw = blockIdx.x * 8 + wave, NGW = GRID * 8;
    bf16* proj = (bf16*)(P.ws + WS_PROJ); bf16* mqk = (bf16*)(P.ws + WS_MQK);
    const float* cw = P.in[I_CONVW] + (size_t)l * 3 * 1024; const float* cb = P.in[I_CONVB] + (size_t)l * 1024;
#pragma unroll 1
    for (int m = gw; m < M; m += NGW) {
        const int t = m & (T - 1);
#pragma unroll
        for (int half = 0; half < 2; ++half) {
            const int c0 = half * 512 + 8 * lane;
            const f32x4 b0 = *(const f32x4*)(cb + c0), b1 = *(const f32x4*)(cb + c0 + 4);
            float y[8] = {b0.x, b0.y, b0.z, b0.w, b1.x, b1.y, b1.z, b1.w};
#pragma unroll
            for (int j = 0; j < 3; ++j) { const int tt = t + j - 1; const float ok = (tt >= 0 && tt < T) ? 1.f : 0.f; const int mc = m + (tt < 0 ? 0 : (tt >= T ? 0 : j - 1));
                const v4u a = *(const v4u*)(proj + (size_t)mc * NPJ + PQ_MQ + c0);
                const f32x4 w0 = *(const f32x4*)(cw + j * 1024 + c0) * ok, w1 = *(const f32x4*)(cw + j * 1024 + c0 + 4) * ok;
                y[0] += w0.x * lo2f(a.x); y[1] += w0.y * hi2f(a.x); y[2] += w0.z * lo2f(a.y); y[3] += w0.w * hi2f(a.y);
                y[4] += w1.x * lo2f(a.z); y[5] += w1.y * hi2f(a.z); y[6] += w1.z * lo2f(a.w); y[7] += w1.w * hi2f(a.w); }
            const float sc = half ? 1.0f : QSCALE;
            *(v4u*)(mqk + (size_t)m * 1024 + c0) = (v4u){pk2(silu_f(y[0]) * sc, silu_f(y[1]) * sc), pk2(silu_f(y[2]) * sc, silu_f(y[3]) * sc), pk2(silu_f(y[4]) * sc, silu_f(y[5]) * sc), pk2(silu_f(y[6]) * sc, silu_f(y[7]) * sc)};
        }
        { const int isk = lane >> 5, hd = (lane >> 3) & 3, ch = lane & 7;
          bf16* rp = proj + (size_t)m * NPJ + (isk ? PQ_RK : PQ_RQ) + hd * 128 + 8 * ch;
          const v4u a = *(const v4u*)rp, pb = *(const v4u*)(rp + 64);
          const float x1[8] = {lo2f(a.x), hi2f(a.x), lo2f(a.y), hi2f(a.y), lo2f(a.z), hi2f(a.z), lo2f(a.w), hi2f(a.w)};
          const float x2[8] = {lo2f(pb.x), hi2f(pb.x), lo2f(pb.y), hi2f(pb.y), lo2f(pb.z), hi2f(pb.z), lo2f(pb.w), hi2f(pb.w)};
          const float sc = isk ? QSCALE : 1.0f; float o1[8], o2[8];
#pragma unroll
          for (int i = 0; i < 8; ++i) { float c, s; rope_cs(t, 8 * ch + i, c, s); o1[i] = (x1[i] * c - x2[i] * s) * sc; o2[i] = (x1[i] * s + x2[i] * c) * sc; }
          *(v4u*)rp = (v4u){pk2(o1[0], o1[1]), pk2(o1[2], o1[3]), pk2(o1[4], o1[5]), pk2(o1[6], o1[7])};
          *(v4u*)(rp + 64) = (v4u){pk2(o2[0], o2[1]), pk2(o2[2], o2[3]), pk2(o2[4], o2[5]), pk2(o2[6], o2[7])}; }
    }
}
template <bool RET> __device__ __forceinline__ v4u k_packed(const Params& P, int b, int t, int h, int ch) {
    if (RET) return *(const v4u*)((const bf16*)(P.ws + WS_PROJ) + (size_t)(b * T + t) * NPJ + PQ_RK + h * 128 + 8 * ch);
    return *(const v4u*)((const bf16*)(P.ws + WS_MQK) + (size_t)(b * T + t) * 1024 + 512 + h * 128 + 8 * ch);
}
template <bool RET> __device__ __forceinline__ void q_frags(const Params& P, int b, int t, int h, int g, bf16x8 (&qf)[4]) {
    const bf16* qp = RET ? (const bf16*)(P.ws + WS_PROJ) + (size_t)(b * T + t) * NPJ + PQ_RQ + h * 128 + 8 * g : (const bf16*)(P.ws + WS_MQK) + (size_t)(b * T + t) * 1024 + h * 128 + 8 * g;
#pragma unroll
    for (int ks = 0; ks < 4; ++ks) qf[ks] = *(const bf16x8*)(qp + 32 * ks);
}
__device__ __forceinline__ float ret_log2g(const Params& P, int l, int dir, int h) { return logsig_f(P.in[I_DECAY][l * 8 + dir * 4 + h]) * LOG2E; }

template <bool RET> __device__ __forceinline__ void lin_local_unit(const Params& P, int l, int b, int h, int oc, LAS unsigned char* lds, int wv) {
    const int tid = tid_fresh(wv), lane = tid & 63, wave = tid >> 6;
    LAS float* sc = (LAS float*)(lds + LDS_SCAL);
    const bf16* proj = (const bf16*)(P.ws + WS_PROJ);
    const size_t i0 = st_idx(RET ? 1 : 0, b, h, 0, oc), i1 = st_idx(RET ? 1 : 0, b, h, 1, oc);
    v4u vv[4], kp[4];
#pragma unroll
    for (int it = 0; it < 4; ++it) {
        const int id = it * 512 + tid, s = id >> 4, ch = id & 15;
        vv[it] = *(const v4u*)(proj + (size_t)(b * T + oc * 128 + s) * NPJ + (RET ? PQ_RV : PQ_MV) + h * 128 + 8 * ch);
        kp[it] = k_packed<RET>(P, b, oc * 128 + s, h, ch);
    }
    float lgF = 0.f, lgB = 0.f;
    if (RET) { lgF = ret_log2g(P, l, 0, h); lgB = ret_log2g(P, l, 1, h); }
    else {
        if (wave == 0) wave_gate_scalars<false, 0>(P, l, b, h, oc, sc, lane, S_T0, 0, 0, i0);
        if (wave == 1) wave_gate_scalars<true, 0>(P, l, b, h, oc, sc, lane, S_T1, 0, 0, i1);
        __syncthreads();
    }
#pragma unroll
    for (int it = 0; it < 4; ++it) {
        const int id = it * 512 + tid, s = id >> 4, ch = id & 15;
        *(LAS v4u*)(lds + LDS_IMG0 + s * IMG_STRIDE + ch * 16) = vv[it];
        const float wF = RET ? __builtin_amdgcn_exp2f((float)(127 - s) * lgF) : sc[S_T0 + s], wB = RET ? __builtin_amdgcn_exp2f((float)s * lgB) : sc[S_T1 + s];
        const float k[8] = {lo2f(kp[it].x), hi2f(kp[it].x), lo2f(kp[it].y), hi2f(kp[it].y), lo2f(kp[it].z), hi2f(kp[it].z), lo2f(kp[it].w), hi2f(kp[it].w)};
        *(LAS v4u*)(lds + LDS_IMG1 + s * IMG_STRIDE + ch * 16) = (v4u){pk2(k[0] * wF, k[1] * wF), pk2(k[2] * wF, k[3] * wF), pk2(k[4] * wF, k[5] * wF), pk2(k[6] * wF, k[7] * wF)};
        *(LAS v4u*)(lds + LDS_IMG2 + s * IMG_STRIDE + ch * 16) = (v4u){pk2(k[0] * wB, k[1] * wB), pk2(k[2] * wB, k[3] * wB), pk2(k[4] * wB, k[5] * wB), pk2(k[6] * wB, k[7] * wB)};
    }
    __syncthreads();
    const int et = wave & 3, dp = wave >> 2;
    f32x16 acc[2][2];
#pragma unroll
    for (int a = 0; a < 2; ++a)
#pragma unroll
        for (int c = 0; c < 2; ++c)
#pragma unroll
            for (int r = 0; r < 16; ++r) acc[a][c][r] = 0.f;
#pragma unroll 2
    for (int ks = 0; ks < 8; ++ks) {
        const bf16x8 av = tr_frag32(lds + LDS_IMG0, 16 * ks, 32 * et, lane);
#pragma unroll
        for (int dir = 0; dir < 2; ++dir)
#pragma unroll
            for (int c = 0; c < 2; ++c) { const bf16x8 bk = tr_frag32(lds + (dir ? LDS_IMG2 : LDS_IMG1), 16 * ks, 32 * (2 * dp + c), lane);
                acc[dir][c] = __builtin_amdgcn_mfma_f32_32x32x16_bf16(av, bk, acc[dir][c], 0, 0, 0); }
    }
    bf16* ct = (bf16*)(P.ws + WS_CLOC);
#pragma unroll
    for (int dir = 0; dir < 2; ++dir)
#pragma unroll
        for (int c = 0; c < 2; ++c)
#pragma unroll
            for (int r = 0; r < 16; ++r) { const int e = 32 * et + (r & 3) + 8 * (r >> 2) + 4 * (lane >> 5), d = 32 * (2 * dp + c) + (lane & 31);
                ct[(dir ? i1 : i0) * 16384 + (size_t)e * 128 + d] = (bf16)(pk2(acc[dir][c][r], 0.f) & 0xffffu); }
    if (!RET && tid < 256) {
        const int dir = tid >> 7, d = tid & 127; const LAS unsigned short* img = (const LAS unsigned short*)(lds + (dir ? LDS_IMG2 : LDS_IMG1)) + d;
        float s = 0.f;
#pragma unroll 8
        for (int r = 0; r < 128; ++r) s += bf2f(img[r * (IMG_STRIDE / 2)]);
        ((float*)(P.ws + WS_NLOC))[(dir ? i1 : i0) * 128 + d] = s;
    }
    __syncthreads();
}
template <bool RET> __device__ __forceinline__ void lin_out_unit(const Params& P, int l, int b, int h, int oc, LAS unsigned char* lds, int wv) {
    const int tid = tid_fresh(wv), lane = tid & 63, wave = tid >> 6, g = lane >> 4, li = lane & 15;
    LAS float* sc = (LAS float*)(lds + LDS_SCAL);
    const bf16* proj = (const bf16*)(P.ws + WS_PROJ);
    const size_t i0 = st_idx(RET ? 1 : 0, b, h, 0, oc), i1 = st_idx(RET ? 1 : 0, b, h, 1, oc);
    const int tq = 16 * wave + li;
    bf16x8 qf[4]; q_frags<RET>(P, b, oc * 128 + tq, h, g, qf);
    v4u vv[4], kp[4], c0v[4], c1v[4];
    { const bf16* ct0 = (const bf16*)(P.ws + WS_CST) + i0 * 16384; const bf16* ct1 = (const bf16*)(P.ws + WS_CST) + i1 * 16384;
#pragma unroll
      for (int it = 0; it < 4; ++it) { const int id = it * 512 + tid, s = id >> 4, ch = id & 15;
        vv[it] = *(const v4u*)(proj + (size_t)(b * T + oc * 128 + s) * NPJ + (RET ? PQ_RV : PQ_MV) + h * 128 + 8 * ch);
        kp[it] = k_packed<RET>(P, b, oc * 128 + s, h, ch);
        c0v[it] = *(const v4u*)(ct0 + (size_t)s * 128 + 8 * ch); c1v[it] = *(const v4u*)(ct1 + (size_t)s * 128 + 8 * ch); } }
#pragma unroll
    for (int it = 0; it < 4; ++it) { const int id = it * 512 + tid, s = id >> 4, ch = id & 15;
        *(LAS v4u*)(lds + LDS_IMG0 + s * IMG_STRIDE + ch * 16) = vv[it]; *(LAS v4u*)(lds + LDS_IMG1 + s * IMG_STRIDE + ch * 16) = kp[it];
        *(LAS v4u*)(lds + LDS_CT0 + s * CT_STRIDE + ch * 16) = c0v[it]; *(LAS v4u*)(lds + LDS_CT0 + CT_BYTES + s * CT_STRIDE + ch * 16) = c1v[it]; }
    float lgF = 0.f, lgB = 0.f;
    if (!RET) {
        if (wave == 0) wave_gate_scalars<false, 1>(P, l, b, h, oc, sc, lane, S_T0, S_BF, S_PMF, 0);
        if (wave == 1) wave_gate_scalars<true, 1>(P, l, b, h, oc, sc, lane, S_T1, S_BB, S_PMB, 0);
    } else {
        lgF = ret_log2g(P, l, 0, h); lgB = ret_log2g(P, l, 1, h);
        if (tid < 128) { sc[S_T0 + tid] = __builtin_amdgcn_exp2f(-(float)tid * lgF); sc[S_T1 + tid] = __builtin_amdgcn_exp2f((float)tid * lgB); }
    }
    __syncthreads();
    f32x4 sT[8];
#pragma unroll
    for (int kt = 0; kt < 8; ++kt) { f32x4 a = {0.f, 0.f, 0.f, 0.f};
#pragma unroll
        for (int ks = 0; ks < 4; ++ks) { const bf16x8 kf = *(const LAS bf16x8*)(lds + LDS_IMG1 + (16 * kt + li) * IMG_STRIDE + (32 * ks + 8 * g) * 2);
            a = __builtin_amdgcn_mfma_f32_16x16x32_bf16(kf, qf[ks], a, 0, 0, 0); }
        sT[kt] = a; }
    float alF, alB, cF, cB;
    float dmF[4], dmB[4];
#pragma unroll
    for (int j = 0; j < 4; ++j) { const int d = 4 * g + j - li; dmF[j] = d <= 0 ? 1.f : 0.f; dmB[j] = d >= 0 ? 1.f : 0.f; }
    if (RET) {
        cF = __builtin_amdgcn_exp2f((float)tq * lgF); cB = __builtin_amdgcn_exp2f(-(float)tq * lgB);
        alF = __builtin_amdgcn_exp2f((float)(tq + 1) * lgF); alB = __builtin_amdgcn_exp2f((float)(128 - tq) * lgB);
    } else {
        const float mCF = ((const float*)(P.ws + WS_MST))[i0], mCB = ((const float*)(P.ws + WS_MST))[i1];
        const float kapF = fmaxf(mCF, sc[S_PMF + tq]), kapB = fmaxf(mCB, sc[S_PMB + tq]);
        const float mF = kapF + sc[S_BF + tq], mB = kapB + sc[S_BB + tq];
        const float wiF = exp_f(mCF - kapF), wiB = exp_f(mCB - kapB);
        const float RF = exp_f(fminf(sc[S_RED + 0] - kapF, 80.f)), RB = exp_f(fminf(sc[S_RED + 1] - kapB, 80.f));
        float sumF = 0.f, sumB = 0.f;
#pragma unroll
        for (int kt = 0; kt < 8; ++kt) { const f32x4 eF = *(const LAS f32x4*)(sc + S_T0 + 16 * kt + 4 * g), eB = *(const LAS f32x4*)(sc + S_T1 + 16 * kt + 4 * g);
            const float tf = kt < wave ? 1.f : 0.f, te = kt == wave ? 1.f : 0.f, tb = kt > wave ? 1.f : 0.f;
#pragma unroll
            for (int j = 0; j < 4; ++j) { sumF += sT[kt][j] * (eF[j] * (tf + te * dmF[j])); sumB += sT[kt][j] * (eB[j] * (tb + te * dmB[j])); } }
        sumF += __shfl_xor(sumF, 16); sumF += __shfl_xor(sumF, 32); sumB += __shfl_xor(sumB, 16); sumB += __shfl_xor(sumB, 32);
        const float* nF = (const float*)(P.ws + WS_NST) + i0 * 128; const float* nB = (const float*)(P.ws + WS_NST) + i1 * 128;
        float qnF = 0.f, qnB = 0.f;
#pragma unroll
        for (int ks = 0; ks < 4; ++ks) { const f32x4 a0 = *(const f32x4*)(nF + 32 * ks + 8 * g), a1 = *(const f32x4*)(nF + 32 * ks + 8 * g + 4), c0 = *(const f32x4*)(nB + 32 * ks + 8 * g), c1 = *(const f32x4*)(nB + 32 * ks + 8 * g + 4);
            const v4u qw = __builtin_bit_cast(v4u, qf[ks]);
            const float q0 = lo2f(qw.x), q1 = hi2f(qw.x), q2 = lo2f(qw.y), q3 = hi2f(qw.y), q4 = lo2f(qw.z), q5 = hi2f(qw.z), q6 = lo2f(qw.w), q7 = hi2f(qw.w);
            qnF += q0 * a0.x + q1 * a0.y + q2 * a0.z + q3 * a0.w + q4 * a1.x + q5 * a1.y + q6 * a1.z + q7 * a1.w;
            qnB += q0 * c0.x + q1 * c0.y + q2 * c0.z + q3 * c0.w + q4 * c1.x + q5 * c1.y + q6 * c1.z + q7 * c1.w; }
        qnF += __shfl_xor(qnF, 16); qnF += __shfl_xor(qnF, 32); qnB += __shfl_xor(qnB, 16); qnB += __shfl_xor(qnB, 32);
        const float denF = RF * sumF + wiF * qnF, denB = RB * sumB + wiB * qnB;
        const float rF = 1.0f / fmaxf(fabsf(denF), exp_f(-mF)), rB = 1.0f / fmaxf(fabsf(denB), exp_f(-mB));
        cF = RF * rF; cB = RB * rB; alF = rF * wiF; alB = rB * wiB;
    }
#pragma unroll
    for (int kt = 0; kt < 8; ++kt) { const f32x4 eF = *(const LAS f32x4*)(sc + S_T0 + 16 * kt + 4 * g), eB = *(const LAS f32x4*)(sc + S_T1 + 16 * kt + 4 * g);
        const float tf = kt < wave ? cF : 0.f, teF = kt == wave ? cF : 0.f, tb = kt > wave ? cB : 0.f, teB = kt == wave ? cB : 0.f;
#pragma unroll
        for (int j = 0; j < 4; ++j) sT[kt][j] *= eF[j] * (tf + teF * dmF[j]) + eB[j] * (tb + teB * dmB[j]); }
    f32x4 O[8];
#pragma unroll
    for (int et = 0; et < 8; ++et) O[et] = (f32x4){0.f, 0.f, 0.f, 0.f};
#pragma unroll
    for (int ks = 0; ks < 4; ++ks) {
        const v4u pw = {pk2(sT[2 * ks][0], sT[2 * ks][1]), pk2(sT[2 * ks][2], sT[2 * ks][3]), pk2(sT[2 * ks + 1][0], sT[2 * ks + 1][1]), pk2(sT[2 * ks + 1][2], sT[2 * ks + 1][3])};
        const bf16x8 pf = __builtin_bit_cast(bf16x8, pw);
#pragma unroll
        for (int et = 0; et < 8; ++et) { const bf16x8 vf = tr_frag16p(lds + LDS_IMG0, IMG_STRIDE, 32 * ks, 16 * et, lane);
            O[et] = __builtin_amdgcn_mfma_f32_16x16x32_bf16(vf, pf, O[et], 0, 0, 0); }
    }
#pragma unroll
    for (int dir = 0; dir < 2; ++dir) {
        const float al = dir ? alB : alF;
#pragma unroll
        for (int et = 0; et < 8; ++et) { f32x4 x = {0.f, 0.f, 0.f, 0.f};
#pragma unroll
            for (int ks = 0; ks < 4; ++ks) { const bf16x8 cf = *(const LAS bf16x8*)(lds + LDS_CT0 + dir * CT_BYTES + (16 * et + li) * CT_STRIDE + (32 * ks + 8 * g) * 2);
                x = __builtin_amdgcn_mfma_f32_16x16x32_bf16(cf, qf[ks], x, 0, 0, 0); }
            O[et] += x * al; }
    }
    asm volatile("" ::: "memory");
    const size_t row = (size_t)(b * T + oc * 128 + tq);
    const bf16* gp = proj + row * NPJ + (RET ? PQ_RG : PQ_MO) + h * 128 + 4 * g;
    const float* gain = P.in[RET ? I_RHN : I_MHN] + (size_t)l * 512 + h * 128 + 4 * g;
    float gt[8][4]; float ss = 0.f;
#pragma unroll
    for (int et = 0; et < 8; ++et) { const v2u w = *(const v2u*)(gp + 16 * et);
        gt[et][0] = lo2f(w.x); gt[et][1] = hi2f(w.x); gt[et][2] = lo2f(w.y); gt[et][3] = hi2f(w.y);
#pragma unroll
        for (int j = 0; j < 4; ++j) { if (!RET) O[et][j] *= sigmoid_f(gt[et][j]); ss += O[et][j] * O[et][j]; } }
    ss += __shfl_xor(ss, 16); ss += __shfl_xor(ss, 32);
    const float rs = rsqrtf(ss * (1.0f / 128.0f) + EPS);
    bf16* op = (bf16*)(P.ws + WS_XN) + row * D + (RET ? 1536 : 0) + h * 128 + 4 * g;
#pragma unroll
    for (int et = 0; et < 8; ++et) { const f32x4 gn = *(const f32x4*)(gain + 16 * et); f32x4 y = O[et] * rs * gn;
        if (RET) { y[0] *= silu_f(gt[et][0]); y[1] *= silu_f(gt[et][1]); y[2] *= silu_f(gt[et][2]); y[3] *= silu_f(gt[et][3]); }
        *(v2u*)(op + 16 * et) = (v2u){pk2(y[0], y[1]), pk2(y[2], y[3])}; }
    __syncthreads();
}

constexpr int NA_TSTRIDE = 288, NA_TBYTES = 64 * NA_TSTRIDE;
__device__ __forceinline__ void na_block_unit(const Params& P, int l, int u, LAS unsigned char* lds, int wv) {
    const int tid = tid_fresh(wv), lane = tid & 63, wave = tid >> 6, g = lane >> 4, li = lane & 15;
    const int rp = u & 15, head = (u >> 4) & 7, b = u >> 7;
    const int n = wave & 3, r = 2 * rp + (wave >> 2);
    const bf16* proj = (const bf16*)(P.ws + WS_PROJ);
    const int r0a = min(max(2 * rp - 4, 0), 24), r0b = min(max(2 * rp - 3, 0), 24), nrows = r0b + 8 - r0a;
    const int r0 = (wave >> 2) ? r0b : r0a, shift = r0 - r0a;
    const int kc0 = (n == 0) ? 0 : (n == 1) ? 8 : (n == 2) ? 24 : 32;
    const int qc = 16 * n + li;
    const size_t qrow = (size_t)(b * T + r * 64 + qc);
    bf16x8 qf[4];
#pragma unroll
    for (int ks = 0; ks < 4; ++ks) qf[ks] = *(const bf16x8*)(proj + qrow * NPJ + PQ_NQ + head * 128 + 32 * ks + 8 * g);
    LAS float* rpb = (LAS float*)(lds + 2 * NA_TBYTES);
    if (tid < 465) rpb[tid] = P.in[I_RPB][((size_t)l * 8 + head) * 465 + tid];
    const int win0 = min(max(qc - 8, 0), 48);
    int dcv[2][4]; bool okv[2][4];
#pragma unroll
    for (int hf = 0; hf < 2; ++hf)
#pragma unroll
        for (int j = 0; j < 4; ++j) { const int kc = kc0 + 16 * hf + 4 * g + j; okv[hf][j] = kc >= win0 && kc < win0 + 16; dcv[hf][j] = min(max(kc - qc + 15, 0), 30); }
    const bf16* kst = proj + (size_t)(b * T + r0a * 64 + (tid >> 4)) * NPJ + PQ_NK + head * 128 + 8 * (tid & 15);
    const bf16* vst = kst + (PQ_NV - PQ_NK);
    LAS unsigned char* wdst = lds + (tid >> 4) * NA_TSTRIDE + (tid & 15) * 16;
    f32x4 sT[16]; float mx = NEGF;
    __syncthreads();
#pragma unroll
    for (int i = 0; i < 8; ++i)
#pragma unroll
        for (int hf = 0; hf < 2; ++hf)
#pragma unroll
            for (int j = 0; j < 4; ++j) sT[2 * i + hf][j] = rpb[(r0 + i - r + 7) * 31 + dcv[hf][j]] * (1.0f / QSCALE);
    constexpr int NA_PF = 4;
    v4u sq[NA_PF][2];
#pragma unroll
    for (int j = 0; j < NA_PF; ++j) { sq[j][0] = *(const v4u*)(kst + (size_t)(j * 64) * NPJ); sq[j][1] = *(const v4u*)(kst + (size_t)(j * 64 + 32) * NPJ); }
#define NA_SROW(I, BUF) do { \
        _Pragma("unroll") for (int hf = 0; hf < 2; ++hf) { f32x4 a_ = sT[2 * (I) + hf]; \
            _Pragma("unroll") for (int ks = 0; ks < 4; ++ks) { const bf16x8 kf_ = *(const LAS bf16x8*)(lds + (BUF) * NA_TBYTES + (kc0 + 16 * hf + li) * NA_TSTRIDE + (32 * ks + 8 * g) * 2); \
                a_ = __builtin_amdgcn_mfma_f32_16x16x32_bf16(kf_, qf[ks], a_, 0, 0, 0); } \
            _Pragma("unroll") for (int j = 0; j < 4; ++j) { const float s_ = okv[hf][j] ? a_[j] * QSCALE : NEGF; a_[j] = s_; mx = fmaxf(mx, s_); } \
            sT[2 * (I) + hf] = a_; } } while (0)
#pragma unroll
    for (int j = 0; j < 9; ++j) {
        if (j < nrows) {
            *(LAS v4u*)(wdst + (j & 1) * NA_TBYTES) = sq[j % NA_PF][0]; *(LAS v4u*)(wdst + (j & 1) * NA_TBYTES + 32 * NA_TSTRIDE) = sq[j % NA_PF][1];
            if (j + NA_PF < nrows) { sq[j % NA_PF][0] = *(const v4u*)(kst + (size_t)((j + NA_PF) * 64) * NPJ); sq[j % NA_PF][1] = *(const v4u*)(kst + (size_t)((j + NA_PF) * 64 + 32) * NPJ); }
            asm volatile("s_waitcnt lgkmcnt(0)" ::: "memory"); __builtin_amdgcn_s_barrier(); asm volatile("" ::: "memory");
            if (shift == 0) { if (j < 8) NA_SROW(j, j & 1); }
            else { if (j >= 1) NA_SROW(j - 1, j & 1); }
        }
    }
#undef NA_SROW
#pragma unroll
    for (int j = 0; j < NA_PF; ++j) { sq[j][0] = *(const v4u*)(vst + (size_t)(j * 64) * NPJ); sq[j][1] = *(const v4u*)(vst + (size_t)(j * 64 + 32) * NPJ); }
    mx = fmaxf(mx, __shfl_xor(mx, 16)); mx = fmaxf(mx, __shfl_xor(mx, 32));
    float sum = 0.f;
#pragma unroll
    for (int kt = 0; kt < 16; ++kt)
#pragma unroll
        for (int j = 0; j < 4; ++j) { const float p = exp_f(sT[kt][j] - mx); sT[kt][j] = p; sum += p; }
    sum += __shfl_xor(sum, 16); sum += __shfl_xor(sum, 32);
    f32x4 O[8];
#pragma unroll
    for (int et = 0; et < 8; ++et) O[et] = (f32x4){0.f, 0.f, 0.f, 0.f};
    __syncthreads();
#define NA_VROW(I, BUF) do { const v4u pw_ = {pk2(sT[2 * (I)][0], sT[2 * (I)][1]), pk2(sT[2 * (I)][2], sT[2 * (I)][3]), pk2(sT[2 * (I) + 1][0], sT[2 * (I) + 1][1]), pk2(sT[2 * (I) + 1][2], sT[2 * (I) + 1][3])}; \
        const bf16x8 pf_ = __builtin_bit_cast(bf16x8, pw_); \
        _Pragma("unroll") for (int et = 0; et < 8; ++et) { const bf16x8 vf_ = tr_frag16p(lds + (BUF) * NA_TBYTES, NA_TSTRIDE, kc0, 16 * et, lane); \
            O[et] = __builtin_amdgcn_mfma_f32_16x16x32_bf16(vf_, pf_, O[et], 0, 0, 0); } } while (0)
#pragma unroll
    for (int j = 0; j < 9; ++j) {
        if (j < nrows) {
            *(LAS v4u*)(wdst + (j & 1) * NA_TBYTES) = sq[j % NA_PF][0]; *(LAS v4u*)(wdst + (j & 1) * NA_TBYTES + 32 * NA_TSTRIDE) = sq[j % NA_PF][1];
            if (j + NA_PF < nrows) { sq[j % NA_PF][0] = *(const v4u*)(vst + (size_t)((j + NA_PF) * 64) * NPJ); sq[j % NA_PF][1] = *(const v4u*)(vst + (size_t)((j + NA_PF) * 64 + 32) * NPJ); }
            asm volatile("s_waitcnt lgkmcnt(0)" ::: "memory"); __builtin_amdgcn_s_barrier(); asm volatile("" ::: "memory");
            if (shift == 0) { if (j < 8) NA_VROW(j, j & 1); }
            else { if (j >= 1) NA_VROW(j - 1, j & 1); }
        }
    }
#undef NA_VROW
    const float rl = 1.0f / sum;
    bf16* op = (bf16*)(P.ws + WS_XN) + qrow * D + 512 + head * 128 + 4 * g;
#pragma unroll
    for (int et = 0; et < 8; ++et) { const f32x4 y = O[et] * rl; *(v2u*)(op + 16 * et) = (v2u){pk2(y[0], y[1]), pk2(y[2], y[3])}; }
    __syncthreads();
}

__device__ __forceinline__ void gate_unit(const Params& P, int l, int item, LAS unsigned char* lds, const unsigned* rowsq, int wv) {
    const int tid = tid_fresh(wv), lane = tid & 63, wave = tid >> 6, g = lane >> 4, li = lane & 15, rt = wave & 3, kh = wave >> 2;
    const bf16* A = (const bf16*)(P.ws + WS_XN) + (size_t)(item * 64 + rt * 16 + li) * D + kh * 1024 + 8 * g;
    const bf16* B = (const bf16*)(P.ws + WS_WIN) + (size_t)(NPJ + li) * D + kh * 1024 + 8 * g;
    f32x4 acc = {0.f, 0.f, 0.f, 0.f};
#pragma unroll 1
    for (int k0 = 0; k0 < 32; k0 += 8) {
        bf16x8 a[8], b[8];
#pragma unroll
        for (int i = 0; i < 8; ++i) { a[i] = *(const bf16x8*)(A + 32 * (k0 + i)); b[i] = *(const bf16x8*)(B + 32 * (k0 + i)); }
#pragma unroll
        for (int i = 0; i < 8; ++i) acc = __builtin_amdgcn_mfma_f32_16x16x32_bf16(a[i], b[i], acc, 0, 0, 0);
    }
    LAS f32x4* xb = (LAS f32x4*)lds + rt * 64 + lane;
    if (kh == 1) *xb = acc;
    __syncthreads();
    if (kh == 0) { const f32x4 o = *xb; float* gp = (float*)(P.ws + WS_GATES) + (size_t)(item * 64 + rt * 16 + 4 * g) * 16 + li;
#pragma unroll
        for (int j = 0; j < 4; ++j) { const float rs = rsqrtf((float)rowsq[item * 64 + rt * 16 + 4 * g + j] * (1.0f / (2048.0f * 4096.0f)) + 1e-6f); gp[j * 16] = (acc[j] + o[j]) * rs; } }
    __syncthreads();
}
__device__ __forceinline__ void scan_phase(const Params& P, int l, int wv) {
    const int gt = blockIdx.x * 512 + tid_fresh(wv), GT = GRID * 512;
    const bf16* cl = (const bf16*)(P.ws + WS_CLOC); bf16* cs = (bf16*)(P.ws + WS_CST);
    const float* mloc = (const float*)(P.ws + WS_MLOC); const float* gtot = (const float*)(P.ws + WS_GTOT);
#pragma unroll 1
    for (int v = gt; v < 128 * 4096 + 64 * 32; v += GT) {
        const bool isn = v >= 128 * 4096;
        const int chain = isn ? (v - 128 * 4096) >> 5 : v >> 12, e4 = isn ? (v - 128 * 4096) & 31 : v & 4095;
        const int typ = chain >> 6, dir = chain & 1, h = (chain >> 1) & 3;
        float dec_r = 0.f; if (typ) dec_r = __builtin_amdgcn_exp2f(128.f * ret_log2g(P, l, dir, h));
        float zz = 0.f; asm volatile("" : "+v"(zz));
        f32x4 st = {zz, zz, zz, zz}; float m = NEGF;
        f32x4 lcv[16];
#pragma unroll
        for (int k = 0; k < 16; ++k) { const int oc = dir ? 15 - k : k; const size_t idx = (size_t)chain * 16 + oc;
            if (isn) lcv[k] = *(const f32x4*)((const float*)(P.ws + WS_NLOC) + idx * 128 + 4 * e4);
            else { const v2u w = *(const v2u*)(cl + idx * 16384 + 4 * e4); lcv[k] = (f32x4){lo2f(w.x), hi2f(w.x), lo2f(w.y), hi2f(w.y)}; } }
#pragma unroll
        for (int k = 0; k < 16; ++k) {
            const int oc = dir ? 15 - k : k; const size_t idx = (size_t)chain * 16 + oc;
            float dec, scl;
            if (typ) { dec = dec_r; scl = 1.f; }
            else { const float gg = gtot[idx], ml = mloc[idx], mn = fmaxf(gg + m, ml); dec = exp_f(gg + m - mn); scl = exp_f(ml - mn);
                if (isn && e4 == 0) ((float*)(P.ws + WS_MST))[idx] = m;
                m = mn; }
            if (isn) { float* ns = (float*)(P.ws + WS_NST) + idx * 128 + 4 * e4; *(f32x4*)ns = st; }
            else { *(v2u*)(cs + idx * 16384 + 4 * e4) = (v2u){pk2(st.x, st.y), pk2(st.z, st.w)}; }
            st = st * dec + lcv[k] * scl;
        }
    }
}
typedef __attribute__((address_space(1))) unsigned gu32;
#define XB_TMO      128
#define XB_XCNT(j)  (256  + 64 * (j))
#define XB_XSUB(j)  (1280 + 64 * (j))
#define XB_XGEN(j)  (2304 + 64 * (j))
#define XB_TOP      3328
#define XB_TOPGEN   3392
#define XCD_BAR_WORDS 3456
#define XB_SPIN_CAP (1u << 18)

__device__ __forceinline__ unsigned xb_ld(unsigned* p)              { return __hip_atomic_load(p, __ATOMIC_RELAXED, __HIP_MEMORY_SCOPE_AGENT); }
__device__ __forceinline__ unsigned xb_add(unsigned* p, unsigned v) { return __hip_atomic_fetch_add(p, v, __ATOMIC_RELAXED, __HIP_MEMORY_SCOPE_AGENT); }
__device__ __forceinline__ unsigned xb_xcc_id() { return (unsigned)__builtin_amdgcn_s_getreg((3 << 11) | 20) & 0xFu; }
#define XB_SPIN(cond, bar) do { unsigned _sp = 0; while (cond) { __builtin_amdgcn_s_sleep(1); \
    if ((++_sp & 255u) == 0u) { if (xb_ld(&(bar)[XB_TMO])) break; if (_sp > XB_SPIN_CAP) { atomicAdd(&(bar)[XB_TMO], 1u); break; } } } } while (0)

struct XcdBarrier {
    unsigned* bar; unsigned x;
    volatile LAS unsigned* st;
};

__device__ __forceinline__ XcdBarrier xcd_barrier_post(unsigned* bar, volatile LAS unsigned* st, int wv) {
    XcdBarrier b; b.bar = bar; b.x = xb_xcc_id(); b.st = st;
    if (wv == 0 && __builtin_amdgcn_mbcnt_hi(~0u, __builtin_amdgcn_mbcnt_lo(~0u, 0u)) == 0u) (void)xb_add(&bar[XB_XCNT(b.x)], 1u);
    return b;
}
__device__ __forceinline__ void xcd_barrier_complete(unsigned* bar, unsigned x, unsigned& nloc, unsigned& nx) {
    const unsigned G = gridDim.x * gridDim.y * gridDim.z;
    unsigned sum, cnt, mine, sp = 0u;
    for (;;) {
        sum = 0u; cnt = 0u; mine = 0u;
#pragma unroll
        for (unsigned j = 0; j < 16; ++j) { const unsigned c = xb_ld(&bar[XB_XCNT(j)]); sum += c; cnt += (c > 0u) ? 1u : 0u; mine = (j == x) ? c : mine; }
        if (sum == G) break;
        __builtin_amdgcn_s_sleep(1);
        if ((++sp & 255u) == 0u) { if (xb_ld(&bar[XB_TMO])) break; if (sp > XB_SPIN_CAP) { atomicAdd(&bar[XB_TMO], 1u); break; } }
    }
    nloc = mine > 0u ? mine : 1u; nx = cnt > 0u ? cnt : 1u;
}

__device__ __forceinline__ void xcd_barrier(const XcdBarrier& b, int wv) {
    asm volatile("s_waitcnt vmcnt(0)" ::: "memory");
    __syncthreads();
    if (wv == 0 && __builtin_amdgcn_mbcnt_hi(~0u, __builtin_amdgcn_mbcnt_lo(~0u, 0u)) == 0u) {
        unsigned* bar = b.bar;
        __builtin_amdgcn_s_waitcnt(0);
        unsigned nloc = b.st[0], nx = b.st[1];
        if (nloc == 0u) { xcd_barrier_complete(bar, b.x, nloc, nx); b.st[0] = nloc; b.st[1] = nx; }
        const unsigned old = xb_add(&bar[XB_XSUB(b.x)], 1u);
        const unsigned gen = old / nloc;
        if (old + 1u == (gen + 1u) * nloc) {
            __builtin_amdgcn_fence(__ATOMIC_RELEASE, "agent");
            asm volatile("s_waitcnt vmcnt(0)" ::: "memory");
            const unsigned og = xb_add(&bar[XB_TOP], 1u);
            const unsigned tg = og / nx;
            if (og + 1u == (tg + 1u) * nx) xb_add(&bar[XB_TOPGEN], 1u);
            else XB_SPIN(xb_ld(&bar[XB_TOPGEN]) == tg, bar);
            __builtin_amdgcn_fence(__ATOMIC_ACQUIRE, "agent");
            xb_add(&bar[XB_XGEN(b.x)], 1u);
            asm volatile("s_waitcnt vmcnt(0)" ::: "memory");
        } else {
            XB_SPIN(xb_ld(&bar[XB_XGEN(b.x)]) == gen, bar);
            __builtin_amdgcn_fence(__ATOMIC_ACQUIRE, "agent");
            asm volatile("s_waitcnt vmcnt(0)" ::: "memory");
        }
    }
    __syncthreads();
}
__device__ __forceinline__ void fill_rstd_table(LAS float* tab, const unsigned* rowsq, int bid, int wv) {
    const int tid = tid_fresh(wv);
#pragma unroll
    for (int i = 0; i < 4; ++i) { const int r = tid + 512 * i; tab[r] = rsqrtf((float)rowsq[(bid & 7) * 2048 + r] * (1.0f / (2048.0f * 4096.0f)) + EPS); }
    __syncthreads();
}
__global__ void __launch_bounds__(512, 2) fwd_kernel(Params P) {
    extern __shared__ __attribute__((aligned(16))) unsigned char lds_raw[];
    LAS unsigned char* lds = (LAS unsigned char*)lds_raw;
    cg::grid_group grid = cg::this_grid();
    const int wv = __builtin_amdgcn_readfirstlane(threadIdx.x >> 6);
    { volatile LAS unsigned* misc = (volatile LAS unsigned*)(lds + MISC_OFF); if (threadIdx.x < 32) misc[threadIdx.x] = 0u;
      if (blockIdx.x == 0) for (int i = threadIdx.x; i < 4096; i += 512) ((unsigned*)P.ws)[i] = 0u; }
    __syncthreads();
    grid.sync();
    const XcdBarrier bar = xcd_barrier_post((unsigned*)P.ws, (volatile LAS unsigned*)(lds + MISC_OFF) + 8, wv);
#define GRID_SYNC() xcd_barrier(bar, wv)
    const int G = GRID, bid = blockIdx.x;
    bf16* xn = (bf16*)(P.ws + WS_XN); bf16* proj = (bf16*)(P.ws + WS_PROJ); bf16* hidden = proj;
    bf16* wgu = (bf16*)(P.ws + WS_WGU); bf16* wdn = (bf16*)(P.ws + WS_WDN); bf16* win = (bf16*)(P.ws + WS_WIN); bf16* wout = (bf16*)(P.ws + WS_WOUT);
    bf16* xnb = (bf16*)(P.ws + WS_CLOC);
    unsigned* rowsq = (unsigned*)(P.ws + WS_ROWSQ);
#pragma unroll 1
    for (int l = 0; l < 2; ++l) {
#if !defined(PH) || (PH & 1)
        convert_weights(P, l, lds, wv);
#endif
        if (l == 0) {
            cast_rows_bf16(P.in[I_X], xn, rowsq, wv);
            unsigned zlo = 0u; asm volatile("" : "+v"(zlo));
#pragma unroll 1
            for (int i = bid * 512 + tid_fresh(wv); i < 8 * M; i += G * 512) __hip_atomic_store(rowsq + M + i, zlo, __ATOMIC_RELAXED, __HIP_MEMORY_SCOPE_AGENT);
        }
        GRID_SYNC();
#pragma unroll 1
        for (int f = 0; f < 2; ++f) {
            if (f == 1) {
#if !defined(PH) || (PH & 128)
                gate_unit(P, l, bid, lds, rowsq + (size_t)(4 * l + 1) * M, wv);
                { pg8::Gemm g{xn, win, M, NPJ, D}; pg8::StaticOrder S; S.init(M, NPJ, G, bid, 4); fill_rstd_table((LAS float*)(lds + 131072), rowsq + (size_t)(4 * l + 1) * M, bid, wv); pg8::EpiProj E{proj, NPJ, (const LAS float*)(lds + 131072)};
                  pg8::gemm_phase<pg8::EpiProj, pg8::StaticOrder, true, true>(lds, g, S, E, wv); }
#endif
                GRID_SYNC();
                prep_phase(P, l, wv);
#pragma unroll 1
                for (int u = (bid & 7) * 32 + (bid >> 3); u < 1024; u += G) {
#if !defined(PH) || (PH & 8)
                    na_block_unit(P, l, u, lds, wv);
#endif
                }
                GRID_SYNC();
#pragma unroll 1
                for (int k4 = 0; k4 < 4; ++k4) { const int u = (k4 >> 1) * 512 + (bid & 7) * 64 + (bid >> 3) + 32 * (k4 & 1);
#if !defined(PH) || (PH & 2)
                    if (u < 512) lin_local_unit<false>(P, l, u >> 6, (u >> 4) & 3, u & 15, lds, wv);
#endif
#if !defined(PH) || (PH & 4)
                    if (u >= 512) lin_local_unit<true>(P, l, (u - 512) >> 6, (u >> 4) & 3, u & 15, lds, wv);
#endif
                }
                GRID_SYNC();
#if !defined(PH) || (PH & 16)
                scan_phase(P, l, wv);
#endif
                GRID_SYNC();
#pragma unroll 1
                for (int k4 = 0; k4 < 4; ++k4) { const int u = (k4 >> 1) * 512 + (bid & 7) * 64 + (bid >> 3) + 32 * (k4 & 1);
#if !defined(PH) || (PH & 32)
                    if (u < 512) lin_out_unit<false>(P, l, u >> 6, (u >> 4) & 3, u & 15, lds, wv);
#endif
#if !defined(PH) || (PH & 64)
                    if (u >= 512) lin_out_unit<true>(P, l, (u - 512) >> 6, (u >> 4) & 3, u & 15, lds, wv);
#endif
                }
                GRID_SYNC();
#if !defined(PH) || (PH & 256)
                { pg8::Gemm g{xn, wout, M, D, D}; pg8::StaticOrder S; S.init(M, D, G, bid, 4); pg8::EpiResid E{P.out, P.out, xnb, rowsq + (size_t)(4 * l + 2) * M, D, 1.0f};
                  pg8::gemm_phase<pg8::EpiResid, pg8::StaticOrder, true, true>(lds, g, S, E, wv); }
#endif
                GRID_SYNC();
            }
#if !defined(PH) || (PH & 512)
            { pg8::Gemm g{f ? xnb : xn, wgu + (size_t)f * NGU * D, M, NGU, D}; pg8::StaticOrder S; S.init(M, NGU, G, bid, 4); fill_rstd_table((LAS float*)(lds + 131072), rowsq + (size_t)(4 * l + 2 * f) * M, bid, wv); pg8::EpiSwiGLU E{hidden, FF, (const LAS float*)(lds + 131072)};
              pg8::gemm_phase<pg8::EpiSwiGLU, pg8::StaticOrder, true, true>(lds, g, S, E, wv); }
#endif
            GRID_SYNC();
#if !defined(PH) || (PH & 1024)
            { pg8::Gemm g{hidden, wdn + (size_t)f * D * FF, M, D, FF}; pg8::StaticOrder S; S.init(M, D, G, bid, 4, 1);
              pg8::EpiResid E{(l == 0 && f == 0) ? P.in[I_X] : P.out, P.out, xn, rowsq + (size_t)(4 * l + (f ? 4 : 1)) * M, D, 0.5f};
              pg8::gemm_phase<pg8::EpiResid, pg8::StaticOrder, true, true>(lds, g, S, E, wv); }
#endif
            GRID_SYNC();
        }
    }
    rms_rows_f32(P.out, P.in[I_FINN], P.out, wv);
}

extern "C" void kernel_launch(void* const* d_in, const int* in_sizes, int n_in, void* d_out, int out_size, void* d_ws, size_t ws_size, hipStream_t stream) {
    static int grid = 0;
    if (grid == 0) {
        if (n_in != 18 || in_sizes[0] != M * D || out_size != M * D || ws_size < WS_END) {
            fprintf(stderr, "kernel_launch: unexpected shapes: n_in %d in0 %d out %d ws %zu (need %zu)\n", n_in, n_in > 0 ? in_sizes[0] : -1, out_size, ws_size, (size_t)WS_END); grid = -1; return; }
        int dev = 0, cus = 0, per_cu = 0;
        (void)hipGetDevice(&dev); (void)hipDeviceGetAttribute(&cus, hipDeviceAttributeMultiprocessorCount, dev);
        (void)hipFuncSetAttribute((const void*)fwd_kernel, hipFuncAttributeMaxDynamicSharedMemorySize, LDS_BYTES);
        (void)hipOccupancyMaxActiveBlocksPerMultiprocessor(&per_cu, (const void*)fwd_kernel, 512, LDS_BYTES);
        if (per_cu < 1) per_cu = 1;
        grid = cus * per_cu;
        if (grid < GRID) { fprintf(stderr, "kernel_launch: this kernel needs %d co-resident workgroups, the device holds %d\n", GRID, grid); grid = -1; return; }
        grid = GRID;
        fprintf(stderr, "kernel_launch: grid %d (cus %d x %d), ws %zu\n", grid, cus, per_cu, ws_size);
    }
    if (grid < 0) return;
    Params p{};
    for (int i = 0; i < 18; ++i) p.in[i] = (const float*)d_in[i];
    p.out = (float*)d_out; p.ws = (unsigned char*)d_ws;
    void* args[] = {&p};
    hipError_t e = hipLaunchCooperativeKernel((const void*)fwd_kernel, dim3(grid), dim3(512), args, LDS_BYTES, stream);
    if (e != hipSuccess) fprintf(stderr, "kernel_launch: cooperative launch failed: %s (grid %d)\n", hipGetErrorString(e), grid);
}
```

```cpp
#include <hip/hip_runtime.h>
#include <hip/hip_cooperative_groups.h>
#include <cstdio>
#include <cstdint>
namespace cg = cooperative_groups;
__device__ __forceinline__ int tid_fresh(int wv) { int t; asm volatile("v_mbcnt_lo_u32_b32 %0, -1, 0\n\tv_mbcnt_hi_u32_b32 %0, -1, %0" : "=v"(t)); return wv * 64 + t; }
namespace pg8 {
#define PG8_LAS __attribute__((address_space(3)))
typedef unsigned short bf16_t;
typedef short bf16x8 __attribute__((ext_vector_type(8)));
typedef float f32x4 __attribute__((ext_vector_type(4)));
typedef unsigned u32x4 __attribute__((ext_vector_type(4)));
constexpr int BM = 256, BK = 64, HALF = 128, HTB = HALF * BK * 2  , STAGE_BYTES = 8 * HTB, NXCD = 8, WGM = 8;

__host__ __device__ __forceinline__ int lds_byte(int r, int c) { const int st = (r >> 4) * 2 + (c >> 5), rr = r & 15, cc = c & 31, ob = rr * 64 + cc * 2; return st * 1024 + (ob ^ (((ob >> 9) & 1) << 5)); }
__host__ __device__ __forceinline__ void stage_rc(int b, int& R, int& C) { const int st = b / 1024, sb = b % 1024, swz = sb ^ (((sb >> 9) & 1) << 5); R = (st >> 1) * 16 + swz / 64; C = (st & 1) * 32 + (swz % 64) / 2; }
__host__ __device__ __forceinline__ int perm32(int rho) { const int n = rho >> 4, i = rho & 15; return 8 * (i >> 2) + 4 * n + (i & 3); }

struct Unit { int pm, pn; };
struct Gemm { const bf16_t* A; const bf16_t* Bt; int M, N, K; };

struct StaticOrder {
    int nM, nN, nwg, G, c, wgm, flip;
    __host__ __device__ void init(int M, int N, int G_, int c_, int wgm_ = WGM, int flip_ = 0) { nM = M / BM; nN = N / BM; nwg = nM * nN; G = G_; c = c_; wgm = wgm_; flip = flip_; }
    __host__ __device__ bool next(int i, Unit& u) const {
        const int R = (nwg + G - 1) / G; if (i >= R) return false; const long L = (long)(flip ? R - 1 - i : i) * G + c; if (L >= nwg) return false;
        int wgid = (int)L; { const int q = nwg / NXCD, r = nwg % NXCD, xcd = wgid % NXCD, off = wgid / NXCD; wgid = (xcd < r ? xcd * (q + 1) : r * (q + 1) + (xcd - r) * q) + off; }
        const int nig = wgm * nN, gid = wgid / nig, fm = gid * wgm, gsz = (nM - fm) < wgm ? (nM - fm) : wgm;
        u.pm = fm + ((wgid % nig) % gsz); u.pn = (wgid % nig) / gsz; return true;
    }
    __device__ __forceinline__ void a_ready(const Unit&) const {}
    __device__ __forceinline__ void done(const Unit&) const {}
};

typedef float f32x2 __attribute__((ext_vector_type(2))); typedef __bf16 bf16x2_t __attribute__((ext_vector_type(2)));
__device__ __forceinline__ unsigned cvt_pk_bf16(float lo, float hi) { f32x2 v = {lo, hi}; bf16x2_t b = __builtin_convertvector(v, bf16x2_t); return __builtin_bit_cast(unsigned, b); }
__device__ __forceinline__ float silu_f(float x) { return x * __builtin_amdgcn_rcpf(1.0f + __builtin_amdgcn_exp2f(-1.4426950408889634f * x)); }
struct EpiSwiGLU {
    static constexpr bool PERM = true, AFTER_DRAIN = false;
    struct Pre {};
    __device__ __forceinline__ Pre prefetch(const Unit&, int, int) const { return Pre{}; }
    bf16_t* O; int ldc; const __attribute__((address_space(3))) float* rstab;
    __device__ __forceinline__ void operator()(const f32x4 (&acc)[2][2][4][2], const Unit& u, int wr, int wc, int fr, int fq, const Pre& pre) const {
        const int row0 = u.pm * BM + wr * 64 + fr, col0 = u.pn * HALF + wc * 32 + 8 * fq;
        float rs[2][4];
#pragma unroll
        for (int ai = 0; ai < 2; ++ai)
#pragma unroll
            for (int m = 0; m < 4; ++m) rs[ai][m] = rstab[(u.pm & 7) * BM + wr * 64 + fr + ai * HALF + m * 16];
#pragma unroll
        for (int ai = 0; ai < 2; ++ai)
#pragma unroll
            for (int m = 0; m < 4; ++m) { bf16_t* rowp = O + (size_t)(row0 + ai * HALF + m * 16) * ldc + col0;
                const f32x4 g0 = acc[ai][0][m][0] * rs[ai][m], g1 = acc[ai][0][m][1] * rs[ai][m], u0 = acc[ai][1][m][0] * rs[ai][m], u1 = acc[ai][1][m][1] * rs[ai][m];
                u32x4 w; w.x = cvt_pk_bf16(silu_f(g0[0]) * u0[0], silu_f(g0[1]) * u0[1]); w.y = cvt_pk_bf16(silu_f(g0[2]) * u0[2], silu_f(g0[3]) * u0[3]);
                w.z = cvt_pk_bf16(silu_f(g1[0]) * u1[0], silu_f(g1[1]) * u1[1]); w.w = cvt_pk_bf16(silu_f(g1[2]) * u1[2], silu_f(g1[3]) * u1[3]);
                *(u32x4*)rowp = w; }
    }
};
struct EpiResid {
    static constexpr bool PERM = false, AFTER_DRAIN = false;
    struct Pre {};
    __device__ __forceinline__ Pre prefetch(const Unit&, int, int) const { return Pre{}; }
    const float* base; float* out; bf16_t* hb; unsigned* rowsq; int ldc; float scale;
    __device__ __forceinline__ void operator()(const f32x4 (&acc)[2][2][4][2], const Unit& u, int wr, int wc, int fr, int fq, const Pre&) const {
        typedef unsigned u32x2 __attribute__((ext_vector_type(2)));
        const int row0 = u.pm * BM + wr * 64 + fr, col0 = u.pn * BM + wc * 32 + 4 * fq;
        float ssv[2][4];
#pragma unroll
        for (int ai = 0; ai < 2; ++ai) {
            f32x4 bs[4][2][2];
#pragma unroll
            for (int m = 0; m < 4; ++m) { const unsigned off = (unsigned)(row0 + ai * HALF + m * 16) * (unsigned)ldc + (unsigned)col0;
#pragma unroll
                for (int bj = 0; bj < 2; ++bj)
#pragma unroll
                    for (int n = 0; n < 2; ++n) bs[m][bj][n] = *(const f32x4*)(base + off + bj * HALF + n * 16); }
            asm volatile("" ::: "memory");
#pragma unroll
            for (int m = 0; m < 4; ++m) { const unsigned off = (unsigned)(row0 + ai * HALF + m * 16) * (unsigned)ldc + (unsigned)col0; float ss = 0.f;
#pragma unroll
                for (int bj = 0; bj < 2; ++bj)
#pragma unroll
                    for (int n = 0; n < 2; ++n) { const f32x4 v = bs[m][bj][n] + acc[ai][bj][m][n] * scale;
                        *(f32x4*)(out + off + bj * HALF + n * 16) = v; *(u32x2*)(hb + off + bj * HALF + n * 16) = (u32x2){cvt_pk_bf16(v[0], v[1]), cvt_pk_bf16(v[2], v[3])};
                        ss += (v[0] * v[0] + v[1] * v[1]) + (v[2] * v[2] + v[3] * v[3]); }
                ssv[ai][m] = ss; }
            asm volatile("" ::: "memory");
        }
#pragma unroll
        for (int ai = 0; ai < 2; ++ai)
#pragma unroll
            for (int m = 0; m < 4; ++m) { float ss = ssv[ai][m]; ss += __shfl_xor(ss, 16); ss += __shfl_xor(ss, 32);
                if (fq == 0) (void)__hip_atomic_fetch_add(rowsq + row0 + ai * HALF + m * 16, (unsigned)(ss * 4096.0f + 0.5f), __ATOMIC_RELAXED, __HIP_MEMORY_SCOPE_AGENT); }
    }
};
struct EpiProj {
    static constexpr bool PERM = true, AFTER_DRAIN = false;
    struct Pre {};
    __device__ __forceinline__ Pre prefetch(const Unit&, int, int) const { return Pre{}; }
    bf16_t* O; int ldc; const __attribute__((address_space(3))) float* rstab;
    __device__ __forceinline__ void operator()(const f32x4 (&acc)[2][2][4][2], const Unit& u, int wr, int wc, int fr, int fq, const Pre& pre) const {
        const int row0 = u.pm * BM + wr * 64 + fr, col0 = u.pn * BM + wc * 32 + 8 * fq;
#pragma unroll
        for (int ai = 0; ai < 2; ++ai)
#pragma unroll
            for (int m = 0; m < 4; ++m) { bf16_t* rowp = O + (size_t)(row0 + ai * HALF + m * 16) * ldc + col0;
                const float rs = rstab[(u.pm & 7) * BM + wr * 64 + fr + ai * HALF + m * 16];
#pragma unroll
                for (int bj = 0; bj < 2; ++bj) { const f32x4 v0 = acc[ai][bj][m][0] * rs, v1 = acc[ai][bj][m][1] * rs;
                    u32x4 w; w.x = cvt_pk_bf16(v0[0], v0[1]); w.y = cvt_pk_bf16(v0[2], v0[3]); w.z = cvt_pk_bf16(v1[0], v1[1]); w.w = cvt_pk_bf16(v1[2], v1[3]);
                    *(u32x4*)(rowp + bj * HALF) = w; } }
    }
};
template <class Epi, class Sched, bool ALIGN_EPI = false, bool SP2 = false>
__device__ __forceinline__ void gemm_phase(PG8_LAS unsigned char* lds, const Gemm g, const Sched S, const Epi E, int wv) {
    const int tid = tid_fresh(wv), wid = __builtin_amdgcn_readfirstlane(tid >> 6), lane = tid & 63, wr = wid >> 2, wc = wid & 3, fr = lane & 15, fq = lane >> 4;
    const int K = g.K, nt = K / BK;
    unsigned voffA[2], voffB[2];
#pragma unroll
    for (int i = 0; i < 2; ++i) { int R, C; stage_rc(tid * 16 + i * 8192, R, C); const int Rb = Epi::PERM ? ((R & ~31) + perm32(R & 31)) : R;
        voffA[i] = (unsigned)(R * K + C) * 2u; voffB[i] = (unsigned)(Rb * K + C) * 2u; }
    const size_t kstep = (size_t)(BK * 2);
    const size_t hstep = (size_t)HALF * K * 2;
    const size_t tstep = 2 * hstep;
    const unsigned ldsw = (unsigned)wid * 1024u;
    const int aoff = lds_byte(wr * 64 + fr, fq * 8), boff = lds_byte(wc * 32 + fr, fq * 8);
#define PG8_SA(b, h) (((b) * 2 + (h)) * HTB)
#define PG8_SB(b, h) ((4 + (b) * 2 + (h)) * HTB)
#define PG8_STAGE(bufoff, gbase, voff) do { _Pragma("unroll") for (int _i = 0; _i < 2; ++_i) \
        __builtin_amdgcn_global_load_lds((const unsigned*)((const char*)(gbase) + (voff)[_i]), (PG8_LAS unsigned*)(lds + (bufoff) + ldsw + _i * 8192), 16, 0, 0); } while (0)
#define PG8_LDA(dst, b, h) do { _Pragma("unroll") for (int m = 0; m < 4; ++m) _Pragma("unroll") for (int k = 0; k < 2; ++k) dst[m][k] = *(const PG8_LAS bf16x8*)(lds + PG8_SA(b, h) + aoff + m * 2048 + k * 1024); } while (0)
#define PG8_LDB(dst, b, h) do { _Pragma("unroll") for (int n = 0; n < 2; ++n) _Pragma("unroll") for (int k = 0; k < 2; ++k) dst[n][k] = *(const PG8_LAS bf16x8*)(lds + PG8_SB(b, h) + boff + n * 2048 + k * 1024); } while (0)
#define PG8_MMA(ai, bj, At, Bt) do { __builtin_amdgcn_s_setprio(1); _Pragma("unroll") for (int m = 0; m < 4; ++m) _Pragma("unroll") for (int n = 0; n < 2; ++n) _Pragma("unroll") for (int k = 0; k < 2; ++k) \
        acc[ai][bj][m][n] = __builtin_amdgcn_mfma_f32_16x16x32_bf16(Bt[n][k], At[m][k], acc[ai][bj][m][n], 0, 0, 0); __builtin_amdgcn_s_setprio(0); } while (0)
#define PG8_WAIT_V(n) asm volatile("s_waitcnt vmcnt(" #n ")" ::: "memory")
#define PG8_WAIT_L(n) asm volatile("s_waitcnt lgkmcnt(" #n ")" ::: "memory")
#define PG8_BAR __builtin_amdgcn_s_barrier()
#define PG8_SCHED __builtin_amdgcn_sched_barrier(0)
    Unit cur, nxt; int ui = 0;
    if (!S.next(0, cur)) return;
    f32x4 acc[2][2][4][2];
#pragma unroll
    for (int a = 0; a < 2; ++a)
#pragma unroll
        for (int b = 0; b < 2; ++b)
#pragma unroll
            for (int m = 0; m < 4; ++m)
#pragma unroll
                for (int n = 0; n < 2; ++n) acc[a][b][m][n] = (f32x4){0.f, 0.f, 0.f, 0.f};
    bf16x8 At[4][2], B0[2][2], B1[2][2];
    const char* cA = (const char*)g.A + (size_t)cur.pm * tstep; const char* cB = (const char*)g.Bt + (size_t)cur.pn * tstep;
    S.a_ready(cur);
    typename Epi::Pre pre = E.prefetch(cur, wr, fr);
    if constexpr (SP2) {
        PG8_STAGE(PG8_SB(0, 0), cB, voffB); PG8_STAGE(PG8_SB(0, 1), cB + hstep, voffB); PG8_STAGE(PG8_SA(0, 0), cA, voffA); PG8_STAGE(PG8_SA(0, 1), cA + hstep, voffA);
        if (wr == 1) PG8_BAR;
        PG8_WAIT_V(2); PG8_BAR;
        PG8_STAGE(PG8_SB(1, 0), cB + kstep, voffB); PG8_STAGE(PG8_SA(1, 0), cA + kstep, voffA); PG8_STAGE(PG8_SB(1, 1), cB + hstep + kstep, voffB);
        PG8_WAIT_V(6); PG8_BAR;
    } else {
        PG8_STAGE(PG8_SB(0, 0), cB, voffB); PG8_STAGE(PG8_SA(0, 0), cA, voffA); PG8_STAGE(PG8_SB(0, 1), cB + hstep, voffB); PG8_STAGE(PG8_SA(0, 1), cA + hstep, voffA);
        if (wr == 1) PG8_BAR;
        PG8_WAIT_V(4); PG8_BAR;
        PG8_STAGE(PG8_SB(1, 0), cB + kstep, voffB); PG8_STAGE(PG8_SA(1, 0), cA + kstep, voffA); PG8_STAGE(PG8_SB(1, 1), cB + hstep + kstep, voffB);
        PG8_WAIT_V(6); PG8_BAR;
    }
    for (;;) {
        const bool has_next = S.next(ui + 1, nxt);
        const char* nA = has_next ? (const char*)g.A + (size_t)nxt.pm * tstep : cA; const char* nB = has_next ? (const char*)g.Bt + (size_t)nxt.pn * tstep : cB;
        for (int t = 0; t < nt; t += 2) {
            const bool last = (t == nt - 2);
            const char* a1 = cA + (size_t)(t + 1) * kstep;
            const char* a2 = last ? nA : cA + (size_t)(t + 2) * kstep; const char* b2 = last ? nB : cB + (size_t)(t + 2) * kstep;
            const char* a3 = a2 + kstep; const char* b3 = b2 + kstep;
            if (last && has_next) S.a_ready(nxt);
            if constexpr (SP2) {
            PG8_LDB(B0, 0, 0); PG8_LDB(B1, 0, 1); PG8_SCHED; PG8_LDA(At, 0, 0); PG8_STAGE(PG8_SA(1, 1), a1 + hstep, voffA);
            PG8_WAIT_V(8); PG8_WAIT_L(0); PG8_BAR; PG8_MMA(0, 0, At, B0); PG8_MMA(0, 1, At, B1); PG8_BAR; PG8_SCHED;
            PG8_LDA(At, 0, 1); PG8_STAGE(PG8_SB(0, 0), b2, voffB); PG8_STAGE(PG8_SB(0, 1), b2 + hstep, voffB); PG8_STAGE(PG8_SA(0, 0), a2, voffA);
            PG8_WAIT_V(8); PG8_WAIT_L(0); PG8_BAR; PG8_MMA(1, 0, At, B0); PG8_MMA(1, 1, At, B1); PG8_BAR; PG8_SCHED;
            PG8_LDB(B0, 1, 0); PG8_LDB(B1, 1, 1); PG8_SCHED; PG8_LDA(At, 1, 0); PG8_STAGE(PG8_SA(0, 1), a2 + hstep, voffA);
            PG8_WAIT_V(8); PG8_WAIT_L(0); PG8_BAR; PG8_MMA(0, 0, At, B0); PG8_MMA(0, 1, At, B1); PG8_BAR; PG8_SCHED;
            PG8_LDA(At, 1, 1); PG8_STAGE(PG8_SB(1, 0), b3, voffB); PG8_STAGE(PG8_SB(1, 1), b3 + hstep, voffB); PG8_STAGE(PG8_SA(1, 0), a3, voffA);
            PG8_WAIT_V(8); PG8_WAIT_L(0); PG8_BAR; PG8_MMA(1, 0, At, B0); PG8_MMA(1, 1, At, B1); PG8_BAR; PG8_SCHED;
            } else {
            PG8_LDB(B0, 0, 0); PG8_SCHED; PG8_LDA(At, 0, 0); PG8_STAGE(PG8_SA(1, 1), a1 + hstep, voffA);
            PG8_WAIT_L(8); PG8_BAR; PG8_WAIT_L(0); PG8_MMA(0, 0, At, B0); PG8_BAR; PG8_SCHED;
            PG8_LDB(B1, 0, 1); PG8_STAGE(PG8_SB(0, 0), b2, voffB);
            PG8_BAR; PG8_WAIT_L(0); PG8_MMA(0, 1, At, B1); PG8_BAR;
            PG8_LDA(At, 0, 1); PG8_STAGE(PG8_SA(0, 0), a2, voffA);
            PG8_BAR; PG8_WAIT_L(0); PG8_MMA(1, 0, At, B0); PG8_BAR; PG8_SCHED;
            PG8_STAGE(PG8_SB(0, 1), b2 + hstep, voffB);
            PG8_WAIT_V(6); PG8_BAR; PG8_MMA(1, 1, At, B1); PG8_BAR;
            PG8_LDB(B0, 1, 0); PG8_SCHED; PG8_LDA(At, 1, 0); PG8_STAGE(PG8_SA(0, 1), a2 + hstep, voffA);
            PG8_WAIT_L(8); PG8_BAR; PG8_WAIT_L(0); PG8_MMA(0, 0, At, B0); PG8_BAR; PG8_SCHED;
            PG8_LDB(B1, 1, 1); PG8_STAGE(PG8_SB(1, 0), b3, voffB);
            PG8_BAR; PG8_WAIT_L(0); PG8_MMA(0, 1, At, B1); PG8_BAR;
            PG8_LDA(At, 1, 1); PG8_STAGE(PG8_SA(1, 0), a3, voffA);
            PG8_BAR; PG8_WAIT_L(0); PG8_MMA(1, 0, At, B0); PG8_BAR; PG8_SCHED;
            PG8_STAGE(PG8_SB(1, 1), b3 + hstep, voffB);
            PG8_WAIT_V(6); PG8_BAR; PG8_MMA(1, 1, At, B1); PG8_BAR;
            }
        }
        if constexpr (ALIGN_EPI) { if (wr == 0) PG8_BAR; }
        if constexpr (!Epi::AFTER_DRAIN) { E(acc, cur, wr, wc, fr, fq, pre); S.done(cur); }
        if (!has_next) break;
#pragma unroll
        for (int a = 0; a < 2; ++a)
#pragma unroll
            for (int b = 0; b < 2; ++b)
#pragma unroll
                for (int m = 0; m < 4; ++m)
#pragma unroll
                    for (int n = 0; n < 2; ++n) acc[a][b][m][n] = (f32x4){0.f, 0.f, 0.f, 0.f};
        cur = nxt; cA = nA; cB = nB; ++ui;
        pre = E.prefetch(cur, wr, fr);
        if constexpr (ALIGN_EPI) { if (wr == 1) PG8_BAR; }
    }
    PG8_WAIT_V(0);
    if constexpr (!ALIGN_EPI) { if (wr == 0) PG8_BAR; }
    PG8_BAR;
    if constexpr (Epi::AFTER_DRAIN) { E.fused(acc, cur, wr, wc, fr, fq, lds, wid, lane); S.done(cur); }
#undef PG8_SA
#undef PG8_SB
#undef PG8_STAGE
#undef PG8_LDA
#undef PG8_LDB
#undef PG8_MMA
#undef PG8_WAIT_V
#undef PG8_WAIT_L
#undef PG8_BAR
#undef PG8_SCHED
}
}
#define LAS __attribute__((address_space(3)))
typedef unsigned short bf16;
typedef unsigned v4u __attribute__((ext_vector_type(4)));
typedef unsigned v2u __attribute__((ext_vector_type(2)));
typedef float f32x4 __attribute__((ext_vector_type(4)));
typedef short bf16x8 __attribute__((ext_vector_type(8)));
typedef short s16x4 __attribute__((ext_vector_type(4)));
typedef short v4i16_t __attribute__((ext_vector_type(4)));
typedef float f32x16 __attribute__((ext_vector_type(16)));

constexpr int NB = 8, T = 2048, M = NB * T, D = 2048, FF = 5632, NGU = 2 * FF, NPJ = 7168, NPJ_PAD = 7424, NIN = 7184, NCH = 16;
constexpr int PQ_MQ = 0, PQ_MK = 512, PQ_MV = 1024, PQ_MO = 1536, PQ_NQ = 2048, PQ_NK = 3072, PQ_NV = 4096, PQ_RQ = 5120, PQ_RK = 5632, PQ_RV = 6144, PQ_RG = 6656;
constexpr float EPS = 1e-6f, NEGF = -1e30f, LOG2E = 1.4426950408889634f, QSCALE = 0.08838834764831845f;
constexpr size_t MiB = 1u << 20;
constexpr size_t WS_WGU = 1 * MiB;
constexpr size_t SZ_WGU = (size_t)NGU * D * 2;
constexpr size_t WS_WDN = WS_WGU + 2 * SZ_WGU;
constexpr size_t SZ_WDN = (size_t)D * FF * 2;
constexpr size_t WS_WIN = WS_WDN + 2 * SZ_WDN;
constexpr size_t WS_WOUT = WS_WIN + (size_t)NPJ_PAD * D * 2;
constexpr size_t WS_XN = WS_WOUT + (size_t)D * D * 2;
constexpr size_t WS_PROJ = WS_XN + (size_t)M * D * 2;
constexpr size_t WS_GATES = WS_PROJ + (size_t)M * NPJ * 2;
constexpr size_t WS_CLOC = WS_GATES + (size_t)M * 16 * 4;
constexpr size_t WS_CST = WS_CLOC + (size_t)2048 * 16384 * 4;
constexpr size_t WS_NLOC = WS_CST + (size_t)2048 * 16384 * 2;
constexpr size_t WS_NST = WS_NLOC + (size_t)1024 * 128 * 4;
constexpr size_t WS_MLOC = WS_NST + (size_t)1024 * 128 * 4;
constexpr size_t WS_GTOT = WS_MLOC + 4096;
constexpr size_t WS_MST = WS_GTOT + 4096;
constexpr size_t WS_ROWSQ = WS_MST + 4096;
constexpr size_t WS_MQK = WS_ROWSQ + (size_t)9 * M * 4;
constexpr size_t WS_END = WS_MQK + (size_t)M * 1024 * 2;
static_assert(WS_END < (size_t)690 * MiB, "workspace map");

struct Params { const float* in[18]; float* out; unsigned char* ws; };
enum { I_X = 0, I_F1N, I_F1GU, I_F1DN, I_MIXN, I_WIN, I_CONVW, I_CONVB, I_GATEB, I_MHN, I_RPB, I_DECAY, I_RHN, I_WOUT, I_F2N, I_F2GU, I_F2DN, I_FINN };

constexpr int LDS_BYTES = 148480, MISC_OFF = 147712, GRID = 256;
constexpr int IMG_STRIDE = 288;
constexpr int IMG_BYTES = 128 * IMG_STRIDE;
constexpr int CT_STRIDE = 272, CT_BYTES = 128 * CT_STRIDE;
constexpr int LDS_IMG0 = 0, LDS_IMG1 = IMG_BYTES, LDS_IMG2 = 2 * IMG_BYTES, LDS_CT0 = 2 * IMG_BYTES, LDS_SCAL = 2 * IMG_BYTES + 2 * CT_BYTES;
static_assert(3 * IMG_BYTES <= LDS_SCAL && LDS_SCAL + 1056 * 4 <= MISC_OFF && MISC_OFF + 128 <= LDS_BYTES, "LDS map");

__device__ __forceinline__ float bf2f(unsigned short b) { return __uint_as_float((unsigned)b << 16); }
__device__ __forceinline__ unsigned pk2(float lo, float hi) { return pg8::cvt_pk_bf16(lo, hi); }
__device__ __forceinline__ float lo2f(unsigned w) { return __uint_as_float(w << 16); }
__device__ __forceinline__ float hi2f(unsigned w) { return __uint_as_float(w & 0xffff0000u); }
__device__ __forceinline__ float wave_sum(float v) {
#pragma unroll
    for (int o = 1; o < 64; o <<= 1) v += __shfl_xor(v, o);
    return v;
}
__device__ __forceinline__ float wave_max(float v) {
#pragma unroll
    for (int o = 1; o < 64; o <<= 1) v = fmaxf(v, __shfl_xor(v, o));
    return v;
}
__device__ __forceinline__ float silu_f(float x) { return pg8::silu_f(x); }
__device__ __forceinline__ float sigmoid_f(float x) { return __builtin_amdgcn_rcpf(1.0f + __builtin_amdgcn_exp2f(-LOG2E * x)); }
__device__ __forceinline__ float logsig_f(float x) { return fminf(x, 0.f) - log1pf(expf(-fabsf(x))); }
__device__ __forceinline__ float exp_f(float x) { return __builtin_amdgcn_exp2f(x * LOG2E); }
__device__ __forceinline__ s16x4 tr_read(const LAS unsigned char* p) { return __builtin_bit_cast(s16x4, __builtin_amdgcn_ds_read_tr16_b64_v4i16((LAS v4i16_t*)p)); }
#define LDS_WAIT() asm volatile("s_waitcnt lgkmcnt(0)" ::: "memory")

template <int MAP> __device__ __forceinline__ int map_row(int n) {
    if (MAP == 1) { const int bj = n >= FF ? 1 : 0, j = n - bj * FF; return (j >> 7) * 256 + bj * 128 + (j & 127); }
    if (MAP == 2) { return n < 2048 ? n : (n < 2064 ? NPJ + (n - 2048) : n - 16); }
    return n;
}
template <int MAP> __device__ __forceinline__ void transpose_item(const float* __restrict__ W, int K, int N, bf16* __restrict__ WT, LAS float* scr, int item, int lane, const float* __restrict__ gain) {
    const int nblk = (N + 31) / 32, kb = item / nblk, nb = item - kb * nblk, k0 = 64 * kb, n0 = 32 * nb;
    const int nq = 4 * (lane & 7), kr = lane >> 3; const bool ok = n0 + nq < N;
    const float* src = W + (size_t)(k0 + kr) * N + (ok ? n0 + nq : 0);
#pragma unroll
    for (int i = 0; i < 8; ++i) { f32x4 v = *(const f32x4*)(src + (size_t)(8 * i) * N); if (!ok) v = (f32x4){0.f, 0.f, 0.f, 0.f};
        LAS float* d = scr + (8 * i + kr) * 33 + nq; d[0] = v.x; d[1] = v.y; d[2] = v.z; d[3] = v.w; }
    LDS_WAIT(); asm volatile("" ::: "memory");
    const int c = lane & 7;
    f32x4 g0 = {1.f, 1.f, 1.f, 1.f}, g1 = {1.f, 1.f, 1.f, 1.f};
    if (gain) { g0 = *(const f32x4*)(gain + k0 + 8 * c); g1 = *(const f32x4*)(gain + k0 + 8 * c + 4); }
#pragma unroll
    for (int j = 0; j < 4; ++j) { const int n = (lane >> 3) + 8 * j; const LAS float* s = scr + (8 * c) * 33 + n;
        v4u o; o.x = pk2(s[0 * 33] * g0.x, s[1 * 33] * g0.y); o.y = pk2(s[2 * 33] * g0.z, s[3 * 33] * g0.w); o.z = pk2(s[4 * 33] * g1.x, s[5 * 33] * g1.y); o.w = pk2(s[6 * 33] * g1.z, s[7 * 33] * g1.w);
        if (n0 + n < N) *(v4u*)(WT + (size_t)map_row<MAP>(n0 + n) * K + k0 + 8 * c) = o; }
    LDS_WAIT(); asm volatile("" ::: "memory");
}
__device__ __forceinline__ void convert_weights(const Params& P, int l, LAS unsigned char* lds, int wv) {
    const int tid = tid_fresh(wv), lane = tid & 63, wave = tid >> 6;
    LAS float* scr = (LAS float*)(lds + wave * 8448);
    const int gw = blockIdx.x * 8 + wave, NGW = GRID * 8;
    bf16* wgu = (bf16*)(P.ws + WS_WGU); bf16* wdn = (bf16*)(P.ws + WS_WDN); bf16* win = (bf16*)(P.ws + WS_WIN); bf16* wout = (bf16*)(P.ws + WS_WOUT);
    constexpr int I_GU = (D / 64) * (NGU / 32), I_DN = (FF / 64) * (D / 32), I_IN = (D / 64) * ((NIN + 31) / 32), I_OUT = (D / 64) * (D / 32);
    constexpr int NITEMS = 2 * I_GU + 2 * I_DN + I_IN + I_OUT;
#pragma unroll 1
    for (int it = gw; it < NITEMS; it += NGW) {
        int r = it;
        if (r < I_GU) { transpose_item<1>(P.in[I_F1GU] + (size_t)l * D * NGU, D, NGU, wgu, scr, r, lane, P.in[I_F1N] + (size_t)l * D); continue; } r -= I_GU;
        if (r < I_GU) { transpose_item<1>(P.in[I_F2GU] + (size_t)l * D * NGU, D, NGU, wgu + (size_t)NGU * D, scr, r, lane, P.in[I_F2N] + (size_t)l * D); continue; } r -= I_GU;
        if (r < I_DN) { transpose_item<0>(P.in[I_F1DN] + (size_t)l * FF * D, FF, D, wdn, scr, r, lane, nullptr); continue; } r -= I_DN;
        if (r < I_DN) { transpose_item<0>(P.in[I_F2DN] + (size_t)l * FF * D, FF, D, wdn + (size_t)D * FF, scr, r, lane, nullptr); continue; } r -= I_DN;
        if (r < I_IN) { transpose_item<2>(P.in[I_WIN] + (size_t)l * D * NIN, D, NIN, win, scr, r, lane, P.in[I_MIXN] + (size_t)l * D); continue; } r -= I_IN;
        transpose_item<0>(P.in[I_WOUT] + (size_t)l * D * D, D, D, wout, scr, r, lane, nullptr);
    }
}
__device__ __forceinline__ void cast_rows_bf16(const float* src, bf16* dst, unsigned* rowsq, int wv) {
    const int tid = tid_fresh(wv), lane = tid & 63, wave = tid >> 6, gw = blockIdx.x * 8 + wave, NGW = GRID * 8;
#pragma unroll 1
    for (int m = gw; m < M; m += NGW) {
        const f32x4* xr = (const f32x4*)(src + (size_t)m * D) + lane;
        f32x4 v[8]; float s = 0.f;
#pragma unroll
        for (int j = 0; j < 8; ++j) { v[j] = xr[64 * j]; s += (v[j].x * v[j].x + v[j].y * v[j].y) + (v[j].z * v[j].z + v[j].w * v[j].w); }
        s = wave_sum(s);
        v2u* o = (v2u*)(dst + (size_t)m * D) + lane;
#pragma unroll
        for (int j = 0; j < 8; ++j) o[64 * j] = (v2u){pk2(v[j].x, v[j].y), pk2(v[j].z, v[j].w)};
        if (lane == 0) rowsq[m] = (unsigned)(s * 4096.0f + 0.5f);
    }
}
__device__ __forceinline__ void rms_rows_f32(const float* src, const float* __restrict__ gain, float* dst, int wv) {
    const int tid = tid_fresh(wv), lane = tid & 63, wave = tid >> 6, gw = blockIdx.x * 8 + wave, NGW = GRID * 8;
    f32x4 gv[8];
#pragma unroll
    for (int j = 0; j < 8; ++j) gv[j] = *(const f32x4*)(gain + 4 * lane + 256 * j);
#pragma unroll 1
    for (int m = gw; m < M; m += NGW) {
        const f32x4* xr = (const f32x4*)(src + (size_t)m * D) + lane;
        f32x4 v[8]; float s = 0.f;
#pragma unroll
        for (int j = 0; j < 8; ++j) { v[j] = xr[64 * j]; s += (v[j].x * v[j].x + v[j].y * v[j].y) + (v[j].z * v[j].z + v[j].w * v[j].w); }
        const float rstd = rsqrtf(wave_sum(s) * (1.f / D) + EPS);
        f32x4* o = (f32x4*)(dst + (size_t)m * D) + lane;
#pragma unroll
        for (int j = 0; j < 8; ++j) o[64 * j] = v[j] * rstd * gv[j];
    }
}
__device__ __forceinline__ size_t st_idx(int typ, int b, int h, int dir, int oc) { return ((((size_t)typ * 8 + b) * 4 + h) * 2 + dir) * 16 + oc; }
__device__ __forceinline__ bf16x8 tr_frag32(const LAS unsigned char* img, int s0, int c0, int lane) {
    const int hh = lane >> 5, grp = (lane >> 4) & 1, q = (lane & 15) >> 2, p = lane & 3;
    const LAS unsigned char* a = img + (s0 + 8 * hh + q) * IMG_STRIDE + (c0 + 16 * grp + 4 * p) * 2;
    const s16x4 lo = tr_read(a), hi = tr_read(a + 4 * IMG_STRIDE);
    return (bf16x8){lo[0], lo[1], lo[2], lo[3], hi[0], hi[1], hi[2], hi[3]};
}
__device__ __forceinline__ bf16x8 tr_frag16p(const LAS unsigned char* img, int stride, int s0, int c0, int lane) {
    const int g = lane >> 4, q = (lane & 15) >> 2, p = lane & 3;
    const LAS unsigned char* a = img + (s0 + 4 * g + q) * stride + (c0 + 4 * p) * 2;
    const s16x4 lo = tr_read(a), hi = tr_read(a + 16 * stride);
    return (bf16x8){lo[0], lo[1], lo[2], lo[3], hi[0], hi[1], hi[2], hi[3]};
}
template <bool REV, bool MAXOP> __device__ __forceinline__ void wave_scan128(const LAS float* in, LAS float* out, int lane) {
    const int i0 = REV ? 127 - 2 * lane : 2 * lane, i1 = REV ? 126 - 2 * lane : 2 * lane + 1;
    const float x0 = in[i0], x1 = in[i1];
    const float pr = MAXOP ? fmaxf(x0, x1) : x0 + x1;
    float s = pr;
#pragma unroll
    for (int o = 1; o < 64; o <<= 1) { const float y = __shfl_up(s, o); if (lane >= o) s = MAXOP ? fmaxf(s, y) : s + y; }
    float ex = __shfl_up(s, 1);
    if (MAXOP) { ex = lane ? ex : NEGF; out[i0] = fmaxf(ex, x0); out[i1] = fmaxf(ex, pr); }
    else { ex = lane ? ex : 0.f; out[i0] = ex + x0; out[i1] = ex + pr; }
}
__device__ __forceinline__ void rope_cs(int pos, int idx, float& c, float& s) {
    const float inv = exp2f(-(float)idx * 0.20762050593046014f);
    float r = (float)pos * inv; r *= 0.15915494309189535f; r -= floorf(r);
    c = __builtin_amdgcn_cosf(r); s = __builtin_amdgcn_sinf(r);
}
enum { S_LIF = 0, S_BF = 128, S_LIB = 256, S_BB = 384, S_T0 = 512, S_T1 = 640, S_PMF = 768, S_PMB = 896, S_RED = 1024 };
__device__ __forceinline__ void mlstm_scalars(const Params& P, int l, int b, int h, int oc, LAS float* sc, int wv) {
    const int tid = tid_fresh(wv), lane = tid & 63, wave = tid >> 6;
    if (tid < 128) {
        const float* g = (const float*)(P.ws + WS_GATES) + (size_t)(b * T + oc * 128 + tid) * 16; const float* gb = P.in[I_GATEB] + l * 16;
        sc[S_LIF + tid] = g[h] + gb[h]; sc[S_T0 + tid] = logsig_f(g[4 + h] + gb[4 + h]);
        sc[S_LIB + tid] = g[8 + h] + gb[8 + h]; sc[S_T1 + tid] = logsig_f(g[12 + h] + gb[12 + h]);
    }
    __syncthreads();
    if (wave == 0) wave_scan128<false, false>(sc + S_T0, sc + S_BF, lane);
    if (wave == 1) wave_scan128<true, false>(sc + S_T1, sc + S_BB, lane);
    __syncthreads();
}
template <bool MAXOP> __device__ __forceinline__ void scan2(float x0, float x1, int lane, float& y0, float& y1) {
    const float pr = MAXOP ? fmaxf(x0, x1) : x0 + x1;
    float s = pr;
#pragma unroll
    for (int o = 1; o < 64; o <<= 1) { const float y = __shfl_up(s, o); if (lane >= o) s = MAXOP ? fmaxf(s, y) : s + y; }
    float ex = __shfl_up(s, 1);
    if (MAXOP) { ex = lane ? ex : NEGF; y0 = fmaxf(ex, x0); y1 = fmaxf(ex, pr); }
    else { ex = lane ? ex : 0.f; y0 = ex + x0; y1 = ex + pr; }
}
template <bool REV, int MODE> __device__ __forceinline__ void wave_gate_scalars(const Params& P, int l, int b, int h, int oc, LAS float* sc, int lane, int wofs, int bofs, int pofs, size_t sidx) {
    const int i0 = REV ? 127 - 2 * lane : 2 * lane, i1 = REV ? 126 - 2 * lane : 2 * lane + 1;
    const float* g = (const float*)(P.ws + WS_GATES) + (size_t)(b * T + oc * 128) * 16; const float* gb = P.in[I_GATEB] + l * 16;
    const int ci = (REV ? 8 : 0) + h, cf = (REV ? 12 : 4) + h;
    const float li0 = g[i0 * 16 + ci] + gb[ci], li1 = g[i1 * 16 + ci] + gb[ci];
    const float lf0 = logsig_f(g[i0 * 16 + cf] + gb[cf]), lf1 = logsig_f(g[i1 * 16 + cf] + gb[cf]);
    float b0, b1; scan2<false>(lf0, lf1, lane, b0, b1);
    if (MODE == 0) {
        const float gtot = __shfl(b1, 63);
        const float a0 = gtot - b0 + li0, a1 = gtot - b1 + li1;
        const float mloc = wave_max(fmaxf(a0, a1));
        sc[wofs + i0] = exp_f(a0 - mloc); sc[wofs + i1] = exp_f(a1 - mloc);
        if (lane == 0) { ((float*)(P.ws + WS_MLOC))[sidx] = mloc; ((float*)(P.ws + WS_GTOT))[sidx] = gtot; }
    } else {
        const float u0 = li0 - b0, u1 = li1 - b1;
        float p0, p1; scan2<true>(u0, u1, lane, p0, p1);
        const float cmax = wave_max(fmaxf(u0, u1));
        sc[bofs + i0] = b0; sc[bofs + i1] = b1; sc[wofs + i0] = exp_f(fmaxf(u0 - cmax, -80.f)); sc[wofs + i1] = exp_f(fmaxf(u1 - cmax, -80.f)); sc[pofs + i0] = p0; sc[pofs + i1] = p1;
        if (lane == 0) sc[S_RED + (REV ? 1 : 0)] = cmax;
    }
}
__device__ __forceinline__ void prep_phase(const Params& P, int l, int wv) {
    const int tid = tid_fresh(wv), lane = tid & 63, wave = tid >> 6, gw = blockIdx.x * 8 + wave, NGW = GRID * 8;
    bf16* proj = (bf16*)(P.ws + WS_PROJ); bf16* mqk = (bf16*)(P.ws + WS_MQK);
    const float* cw = P.in[I_CONVW] + (size_t)l * 3 * 1024; const float* cb = P.in[I_CONVB] + (size_t)l * 1024;
#pragma unroll 1
    for (int m = gw; m < M; m += NGW) {
        const int t = m & (T - 1);
#pragma unroll
        for (int half = 0; half < 2; ++half) {
            const int c0 = half * 512 + 8 * lane;
            const f32x4 b0 = *(const f32x4*)(cb + c0), b1 = *(const f32x4*)(cb + c0 + 4);
            float y[8] = {b0.x, b0.y, b0.z, b0.w, b1.x, b1.y, b1.z, b1.w};
#pragma unroll
            for (int j = 0; j < 3; ++j) { const int tt = t + j - 1; const float ok = (tt >= 0 && tt < T) ? 1.f : 0.f; const int mc = m + (tt < 0 ? 0 : (tt >= T ? 0 : j - 1));
                const v4u a = *(const v4u*)(proj + (size_t)mc * NPJ + PQ_MQ + c0);
                const f32x4 w0 = *(const f32x4*)(cw + j * 1024 + c0) * ok, w1 = *(const f32x4*)(cw + j * 1024 + c0 + 4) * ok;
                y[0] += w0.x * lo2f(a.x); y[1] += w0.y * hi2f(a.x); y[2] += w0.z * lo2f(a.y); y[3] += w0.w * hi2f(a.y);
                y[4] += w1.x * lo2f(a.z); y[5] += w1.y * hi2f(a.z); y[6] += w1.z * lo2f(a.w); y[7] += w1.w * hi2f(a.w); }
            const float sc = half ? 1.0f : QSCALE;
            *(v4u*)(mqk + (size_t)m * 1024 + c0) = (v4u){pk2(silu_f(y[0]) * sc, silu_f(y[1]) * sc), pk2(silu_f(y[2]) * sc, silu_f(y[3]) * sc), pk2(silu_f(y[4]) * sc, silu_f(y[5]) * sc), pk2(silu_f(y[6]) * sc, silu_f(y[7]) * sc)};
        }
        { const int isk = lane >> 5, hd = (lane >> 3) & 3, ch = lane & 7;
          bf16* rp = proj + (size_t)m * NPJ + (isk ? PQ_RK : PQ_RQ) + hd * 128 + 8 * ch;
          const v4u a = *(const v4u*)rp, pb = *(const v4u*)(rp + 64);
          const float x1[8] = {lo2f(a.x), hi2f(a.x), lo2f(a.y), hi2f(a.y), lo2f(a.z), hi2f(a.z), lo2f(a.w), hi2f(a.w)};
          const float x2[8] = {lo2f(pb.x), hi2f(pb.x), lo2f(pb.y), hi2f(pb.y), lo2f(pb.z), hi2f(pb.z), lo2f(pb.w), hi2f(pb.w)};
          const float sc = isk ? QSCALE : 1.0f; float o1[8], o2[8];
#pragma unroll
          for (int i = 0; i < 8; ++i) { float c, s; rope_cs(t, 8 * ch + i, c, s); o1[i] = (x1[i] * c - x2[i] * s) * sc; o2[i] = (x1[i] * s + x2[i] * c) * sc; }
          *(v4u*)rp = (v4u){pk2(o1[0], o1[1]), pk2(o1[2], o1[3]), pk2(o1[4], o1[5]), pk2(o1[6], o1[7])};
          *(v4u*)(rp + 64) = (v4u){pk2(o2[0], o2[1]), pk2(o2[2], o2[3]), pk2(o2[4], o2[5]), pk2(o2[6], o2[7])}; }
    }
}
template <bool RET> __device__ __forceinline__ v4u k_packed(const Params& P, int b, int t, int h, int ch) {
    if (RET) return *(const v4u*)((const bf16*)(P.ws + WS_PROJ) + (size_t)(b * T + t) * NPJ + PQ_RK + h * 128 + 8 * ch);
    return *(const v4u*)((const bf16*)(P.ws + WS_MQK) + (size_t)(b * T + t) * 1024 + 512 + h * 128 + 8 * ch);
}
template <bool RET> __device__ __forceinline__ void q_frags(const Params& P, int b, int t, int h, int g, bf16x8 (&qf)[4]) {
    const bf16* qp = RET ? (const bf16*)(P.ws + WS_PROJ) + (size_t)(b * T + t) * NPJ + PQ_RQ + h * 128 + 8 * g : (const bf16*)(P.ws + WS_MQK) + (size_t)(b * T + t) * 1024 + h * 128 + 8 * g;
#pragma unroll
    for (int ks = 0; ks < 4; ++ks) qf[ks] = *(const bf16x8*)(qp + 32 * ks);
}
__device__ __forceinline__ float ret_log2g(const Params& P, int l, int dir, int h) { return logsig_f(P.in[I_DECAY][l * 8 + dir * 4 + h]) * LOG2E; }

template <bool RET> __device__ __forceinline__ void lin_local_unit(const Params& P, int l, int b, int h, int oc, LAS unsigned char* lds, int wv) {
    const int tid = tid_fresh(wv), lane = tid & 63, wave = tid >> 6;
    LAS float* sc = (LAS float*)(lds + LDS_SCAL);
    const bf16* proj = (const bf16*)(P.ws + WS_PROJ);
    const size_t i0 = st_idx(RET ? 1 : 0, b, h, 0, oc), i1 = st_idx(RET ? 1 : 0, b, h, 1, oc);
    v4u vv[4], kp[4];
#pragma unroll
    for (int it = 0; it < 4; ++it) {
        const int id = it * 512 + tid, s = id >> 4, ch = id & 15;
        vv[it] = *(const v4u*)(proj + (size_t)(b * T + oc * 128 + s) * NPJ + (RET ? PQ_RV : PQ_MV) + h * 128 + 8 * ch);
        kp[it] = k_packed<RET>(P, b, oc * 128 + s, h, ch);
    }
    float lgF = 0.f, lgB = 0.f;
    if (RET) { lgF = ret_log2g(P, l, 0, h); lgB = ret_log2g(P, l, 1, h); }
    else {
        if (wave == 0) wave_gate_scalars<false, 0>(P, l, b, h, oc, sc, lane, S_T0, 0, 0, i0);
        if (wave == 1) wave_gate_scalars<true, 0>(P, l, b, h, oc, sc, lane, S_T1, 0, 0, i1);
        __syncthreads();
    }
#pragma unroll
    for (int it = 0; it < 4; ++it) {
        const int id = it * 512 + tid, s = id >> 4, ch = id & 15;
        *(LAS v4u*)(lds + LDS_IMG0 + s * IMG_STRIDE + ch * 16) = vv[it];
        const float wF = RET ? __builtin_amdgcn_exp2f((float)(127 - s) * lgF) : sc[S_T0 + s], wB = RET ? __builtin_amdgcn_exp2f((float)s * lgB) : sc[S_T1 + s];
        const float k[8] = {lo2f(kp[it].x), hi2f(kp[it].x), lo2f(kp[it].y), hi2f(kp[it].y), lo2f(kp[it].z), hi2f(kp[it].z), lo2f(kp[it].w), hi2f(kp[it].w)};
        *(LAS v4u*)(lds + LDS_IMG1 + s * IMG_STRIDE + ch * 16) = (v4u){pk2(k[0] * wF, k[1] * wF), pk2(k[2] * wF, k[3] * wF), pk2(k[4] * wF, k[5] * wF), pk2(k[6] * wF, k[7] * wF)};
        *(LAS v4u*)(lds + LDS_IMG2 + s * IMG_STRIDE + ch * 16) = (v4u){pk2(k[0] * wB, k[1] * wB), pk2(k[2] * wB, k[3] * wB), pk2(k[4] * wB, k[5] * wB), pk2(k[6] * wB, k[7] * wB)};
    }
    __syncthreads();
    const int et = wave & 3, dp = wave >> 2;
    f32x16 acc[2][2];
#pragma unroll
    for (int a = 0; a < 2; ++a)
#pragma unroll
        for (int c = 0; c < 2; ++c)
#pragma unroll
            for (int r = 0; r < 16; ++r) acc[a][c][r] = 0.f;
#pragma unroll 2
    for (int ks = 0; ks < 8; ++ks) {
        const bf16x8 av = tr_frag32(lds + LDS_IMG0, 16 * ks, 32 * et, lane);
#pragma unroll
        for (int dir = 0; dir < 2; ++dir)
#pragma unroll
            for (int c = 0; c < 2; ++c) { const bf16x8 bk = tr_frag32(lds + (dir ? LDS_IMG2 : LDS_IMG1), 16 * ks, 32 * (2 * dp + c), lane);
                acc[dir][c] = __builtin_amdgcn_mfma_f32_32x32x16_bf16(av, bk, acc[dir][c], 0, 0, 0); }
    }
    bf16* ct = (bf16*)(P.ws + WS_CLOC);
#pragma unroll
    for (int dir = 0; dir < 2; ++dir)
#pragma unroll
        for (int c = 0; c < 2; ++c)
#pragma unroll
            for (int r = 0; r < 16; ++r) { const int e = 32 * et + (r & 3) + 8 * (r >> 2) + 4 * (lane >> 5), d = 32 * (2 * dp + c) + (lane & 31);
                ct[(dir ? i1 : i0) * 16384 + (size_t)e * 128 + d] = (bf16)(pk2(acc[dir][c][r], 0.f) & 0xffffu); }
    if (!RET && tid < 256) {
        const int dir = tid >> 7, d = tid & 127; const LAS unsigned short* img = (const LAS unsigned short*)(lds + (dir ? LDS_IMG2 : LDS_IMG1)) + d;
        float s = 0.f;
#pragma unroll 8
        for (int r = 0; r < 128; ++r) s += bf2f(img[r * (IMG_STRIDE / 2)]);
        ((float*)(P.ws + WS_NLOC))[(dir ? i1 : i0) * 128 + d] = s;
    }
    __syncthreads();
}
template <bool RET> __device__ __forceinline__ void lin_out_unit(const Params& P, int l, int b, int h, int oc, LAS unsigned char* lds, int wv) {
    const int tid = tid_fresh(wv), lane = tid & 63, wave = tid >> 6, g = lane >> 4, li = lane & 15;
    LAS float* sc = (LAS float*)(lds + LDS_SCAL);
    const bf16* proj = (const bf16*)(P.ws + WS_PROJ);
    const size_t i0 = st_idx(RET ? 1 : 0, b, h, 0, oc), i1 = st_idx(RET ? 1 : 0, b, h, 1, oc);
    const int tq = 16 * wave + li;
    bf16x8 qf[4]; q_frags<RET>(P, b, oc * 128 + tq, h, g, qf);
    v4u vv[4], kp[4], c0v[4], c1v[4];
    { const bf16* ct0 = (const bf16*)(P.ws + WS_CST) + i0 * 16384; const bf16* ct1 = (const bf16*)(P.ws + WS_CST) + i1 * 16384;
#pragma unroll
      for (int it = 0; it < 4; ++it) { const int id = it * 512 + tid, s = id >> 4, ch = id & 15;
        vv[it] = *(const v4u*)(proj + (size_t)(b * T + oc * 128 + s) * NPJ + (RET ? PQ_RV : PQ_MV) + h * 128 + 8 * ch);
        kp[it] = k_packed<RET>(P, b, oc * 128 + s, h, ch);
        c0v[it] = *(const v4u*)(ct0 + (size_t)s * 128 + 8 * ch); c1v[it] = *(const v4u*)(ct1 + (size_t)s * 128 + 8 * ch); } }
#pragma unroll
    for (int it = 0; it < 4; ++it) { const int id = it * 512 + tid, s = id >> 4, ch = id & 15;
        *(LAS v4u*)(lds + LDS_IMG0 + s * IMG_STRIDE + ch * 16) = vv[it]; *(LAS v4u*)(lds + LDS_IMG1 + s * IMG_STRIDE + ch * 16) = kp[it];
        *(LAS v4u*)(lds + LDS_CT0 + s * CT_STRIDE + ch * 16) = c0v[it]; *(LAS v4u*)(lds + LDS_CT0 + CT_BYTES + s * CT_STRIDE + ch * 16) = c1v[it]; }
    float lgF = 0.f, lgB = 0.f;
    if (!RET) {
        if (wave == 0) wave_gate_scalars<false, 1>(P, l, b, h, oc, sc, lane, S_T0, S_BF, S_PMF, 0);
        if (wave == 1) wave_gate_scalars<true, 1>(P, l, b, h, oc, sc, lane, S_T1, S_BB, S_PMB, 0);
    } else {
        lgF = ret_log2g(P, l, 0, h); lgB = ret_log2g(P, l, 1, h);
        if (tid < 128) { sc[S_T0 + tid] = __builtin_amdgcn_exp2f(-(float)tid * lgF); sc[S_T1 + tid] = __builtin_amdgcn_exp2f((float)tid * lgB); }
    }
    __syncthreads();
    f32x4 sT[8];
#pragma unroll
    for (int kt = 0; kt < 8; ++kt) { f32x4 a = {0.f, 0.f, 0.f, 0.f};
#pragma unroll
        for (int ks = 0; ks < 4; ++ks) { const bf16x8 kf = *(const LAS bf16x8*)(lds + LDS_IMG1 + (16 * kt + li) * IMG_STRIDE + (32 * ks + 8 * g) * 2);
            a = __builtin_amdgcn_mfma_f32_16x16x32_bf16(kf, qf[ks], a, 0, 0, 0); }
        sT[kt] = a; }
    float alF, alB, cF, cB;
    float dmF[4], dmB[4];
#pragma unroll
    for (int j = 0; j < 4; ++j) { const int d = 4 * g + j - li; dmF[j] = d <= 0 ? 1.f : 0.f; dmB[j] = d >= 0 ? 1.f : 0.f; }
    if (RET) {
        cF = __builtin_amdgcn_exp2f((float)tq * lgF); cB = __builtin_amdgcn_exp2f(-(float)tq * lgB);
        alF = __builtin_amdgcn_exp2f((float)(tq + 1) * lgF); alB = __builtin_amdgcn_exp2f((float)(128 - tq) * lgB);
    } else {
        const float mCF = ((const float*)(P.ws + WS_MST))[i0], mCB = ((const float*)(P.ws + WS_MST))[i1];
        const float kapF = fmaxf(mCF, sc[S_PMF + tq]), kapB = fmaxf(mCB, sc[S_PMB + tq]);
        const float mF = kapF + sc[S_BF + tq], mB = kapB + sc[S_BB + tq];
        const float wiF = exp_f(mCF - kapF), wiB = exp_f(mCB - kapB);
        const float RF = exp_f(fminf(sc[S_RED + 0] - kapF, 80.f)), RB = exp_f(fminf(sc[S_RED + 1] - kapB, 80.f));
        float sumF = 0.f, sumB = 0.f;
#pragma unroll
        for (int kt = 0; kt < 8; ++kt) { const f32x4 eF = *(const LAS f32x4*)(sc + S_T0 + 16 * kt + 4 * g), eB = *(const LAS f32x4*)(sc + S_T1 + 16 * kt + 4 * g);
            const float tf = kt < wave ? 1.f : 0.f, te = kt == wave ? 1.f : 0.f, tb = kt > wave ? 1.f : 0.f;
#pragma unroll
            for (int j = 0; j < 4; ++j) { sumF += sT[kt][j] * (eF[j] * (tf + te * dmF[j])); sumB += sT[kt][j] * (eB[j] * (tb + te * dmB[j])); } }
        sumF += __shfl_xor(sumF, 16); sumF += __shfl_xor(sumF, 32); sumB += __shfl_xor(sumB, 16); sumB += __shfl_xor(sumB, 32);
        const float* nF = (const float*)(P.ws + WS_NST) + i0 * 128; const float* nB = (const float*)(P.ws + WS_NST) + i1 * 128;
        float qnF = 0.f, qnB = 0.f;
#pragma unroll
        for (int ks = 0; ks < 4; ++ks) { const f32x4 a0 = *(const f32x4*)(nF + 32 * ks + 8 * g), a1 = *(const f32x4*)(nF + 32 * ks + 8 * g + 4), c0 = *(const f32x4*)(nB + 32 * ks + 8 * g), c1 = *(const f32x4*)(nB + 32 * ks + 8 * g + 4);
            const v4u qw = __builtin_bit_cast(v4u, qf[ks]);
            const float q0 = lo2f(qw.x), q1 = hi2f(qw.x), q2 = lo2f(qw.y), q3 = hi2f(qw.y), q4 = lo2f(qw.z), q5 = hi2f(qw.z), q6 = lo2f(qw.w), q7 = hi2f(qw.w);
            qnF += q0 * a0.x + q1 * a0.y + q2 * a0.z + q3 * a0.w + q4 * a1.x + q5 * a1.y + q6 * a1.z + q7 * a1.w;
            qnB += q0 * c0.x + q1 * c0.y + q2 * c0.z + q3 * c0.w + q4 * c1.x + q5 * c1.y + q6 * c1.z + q7 * c1.w; }
        qnF += __shfl_xor(qnF, 16); qnF += __shfl_xor(qnF, 32); qnB += __shfl_xor(qnB, 16); qnB += __shfl_xor(qnB, 32);
        const float denF = RF * sumF + wiF * qnF, denB = RB * sumB + wiB * qnB;
        const float rF = 1.0f / fmaxf(fabsf(denF), exp_f(-mF)), rB = 1.0f / fmaxf(fabsf(denB), exp_f(-mB));
        cF = RF * rF; cB = RB * rB; alF = rF * wiF; alB = rB * wiB;
    }
#pragma unroll
    for (int kt = 0; kt < 8; ++kt) { const f32x4 eF = *(const LAS f32x4*)(sc + S_T0 + 16 * kt + 4 * g), eB = *(const LAS f32x4*)(sc + S_T1 + 16 * kt + 4 * g);
        const float tf = kt < wave ? cF : 0.f, teF = kt == wave ? cF : 0.f, tb = kt > wave ? cB : 0.f, teB = kt == wave ? cB : 0.f;
#pragma unroll
        for (int j = 0; j < 4; ++j) sT[kt][j] *= eF[j] * (tf + teF * dmF[j]) + eB[j] * (tb + teB * dmB[j]); }
    f32x4 O[8];
#pragma unroll
    for (int et = 0; et < 8; ++et) O[et] = (f32x4){0.f, 0.f, 0.f, 0.f};
#pragma unroll
    for (int ks = 0; ks < 4; ++ks) {
        const v4u pw = {pk2(sT[2 * ks][0], sT[2 * ks][1]), pk2(sT[2 * ks][2], sT[2 * ks][3]), pk2(sT[2 * ks + 1][0], sT[2 * ks + 1][1]), pk2(sT[2 * ks + 1][2], sT[2 * ks + 1][3])};
        const bf16x8 pf = __builtin_bit_cast(bf16x8, pw);
#pragma unroll
        for (int et = 0; et < 8; ++et) { const bf16x8 vf = tr_frag16p(lds + LDS_IMG0, IMG_STRIDE, 32 * ks, 16 * et, lane);
            O[et] = __builtin_amdgcn_mfma_f32_16x16x32_bf16(vf, pf, O[et], 0, 0, 0); }
    }
#pragma unroll
    for (int dir = 0; dir < 2; ++dir) {
        const float al = dir ? alB : alF;
#pragma unroll
        for (int et = 0; et < 8; ++et) { f32x4 x = {0.f, 0.f, 0.f, 0.f};
#pragma unroll
            for (int ks = 0; ks < 4; ++ks) { const bf16x8 cf = *(const LAS bf16x8*)(lds + LDS_CT0 + dir * CT_BYTES + (16 * et + li) * CT_STRIDE + (32 * ks + 8 * g) * 2);
                x = __builtin_amdgcn_mfma_f32_16x16x32_bf16(cf, qf[ks], x, 0, 0, 0); }
            O[et] += x * al; }
    }
    asm volatile("" ::: "memory");
    const size_t row = (size_t)(b * T + oc * 128 + tq);
    const bf16* gp = proj + row * NPJ + (RET ? PQ_RG : PQ_MO) + h * 128 + 4 * g;
    const float* gain = P.in[RET ? I_RHN : I_MHN] + (size_t)l * 512 + h * 128 + 4 * g;
    float gt[8][4]; float ss = 0.f;
#pragma unroll
    for (int et = 0; et < 8; ++et) { const v2u w = *(const v2u*)(gp + 16 * et);
        gt[et][0] = lo2f(w.x); gt[et][1] = hi2f(w.x); gt[et][2] = lo2f(w.y); gt[et][3] = hi2f(w.y);
#pragma unroll
        for (int j = 0; j < 4; ++j) { if (!RET) O[et][j] *= sigmoid_f(gt[et][j]); ss += O[et][j] * O[et][j]; } }
    ss += __shfl_xor(ss, 16); ss += __shfl_xor(ss, 32);
    const float rs = rsqrtf(ss * (1.0f / 128.0f) + EPS);
    bf16* op = (bf16*)(P.ws + WS_XN) + row * D + (RET ? 1536 : 0) + h * 128 + 4 * g;
#pragma unroll
    for (int et = 0; et < 8; ++et) { const f32x4 gn = *(const f32x4*)(gain + 16 * et); f32x4 y = O[et] * rs * gn;
        if (RET) { y[0] *= silu_f(gt[et][0]); y[1] *= silu_f(gt[et][1]); y[2] *= silu_f(gt[et][2]); y[3] *= silu_f(gt[et][3]); }
        *(v2u*)(op + 16 * et) = (v2u){pk2(y[0], y[1]), pk2(y[2], y[3])}; }
    __syncthreads();
}

constexpr int NA_TSTRIDE = 288, NA_TBYTES = 64 * NA_TSTRIDE;
__device__ __forceinline__ void na_block_unit(const Params& P, int l, int u, LAS unsigned char* lds, int wv) {
    const int tid = tid_fresh(wv), lane = tid & 63, wave = tid >> 6, g = lane >> 4, li = lane & 15;
    const int rp = u & 15, head = (u >> 4) & 7, b = u >> 7;
    const int n = wave & 3, r = 2 * rp + (wave >> 2);
    const bf16* proj = (const bf16*)(P.ws + WS_PROJ);
    const int r0a = min(max(2 * rp - 4, 0), 24), r0b = min(max(2 * rp - 3, 0), 24), nrows = r0b + 8 - r0a;
    const int r0 = (wave >> 2) ? r0b : r0a, shift = r0 - r0a;
    const int kc0 = (n == 0) ? 0 : (n == 1) ? 8 : (n == 2) ? 24 : 32;
    const int qc = 16 * n + li;
    const size_t qrow = (size_t)(b * T + r * 64 + qc);
    bf16x8 qf[4];
#pragma unroll
    for (int ks = 0; ks < 4; ++ks) qf[ks] = *(const bf16x8*)(proj + qrow * NPJ + PQ_NQ + head * 128 + 32 * ks + 8 * g);
    LAS float* rpb = (LAS float*)(lds + 2 * NA_TBYTES);
    if (tid < 465) rpb[tid] = P.in[I_RPB][((size_t)l * 8 + head) * 465 + tid];
    const int win0 = min(max(qc - 8, 0), 48);
    int dcv[2][4]; bool okv[2][4];
#pragma unroll
    for (int hf = 0; hf < 2; ++hf)
#pragma unroll
        for (int j = 0; j < 4; ++j) { const int kc = kc0 + 16 * hf + 4 * g + j; okv[hf][j] = kc >= win0 && kc < win0 + 16; dcv[hf][j] = min(max(kc - qc + 15, 0), 30); }
    const bf16* kst = proj + (size_t)(b * T + r0a * 64 + (tid >> 4)) * NPJ + PQ_NK + head * 128 + 8 * (tid & 15);
    const bf16* vst = kst + (PQ_NV - PQ_NK);
    LAS unsigned char* wdst = lds + (tid >> 4) * NA_TSTRIDE + (tid & 15) * 16;
    f32x4 sT[16]; float mx = NEGF;
    __syncthreads();
#pragma unroll
    for (int i = 0; i < 8; ++i)
#pragma unroll
        for (int hf = 0; hf < 2; ++hf)
#pragma unroll
            for (int j = 0; j < 4; ++j) sT[2 * i + hf][j] = rpb[(r0 + i - r + 7) * 31 + dcv[hf][j]] * (1.0f / QSCALE);
    constexpr int NA_PF = 4;
    v4u sq[NA_PF][2];
#pragma unroll
    for (int j = 0; j < NA_PF; ++j) { sq[j][0] = *(const v4u*)(kst + (size_t)(j * 64) * NPJ); sq[j][1] = *(const v4u*)(kst + (size_t)(j * 64 + 32) * NPJ); }
#define NA_SROW(I, BUF) do { \
        _Pragma("unroll") for (int hf = 0; hf < 2; ++hf) { f32x4 a_ = sT[2 * (I) + hf]; \
            _Pragma("unroll") for (int ks = 0; ks < 4; ++ks) { const bf16x8 kf_ = *(const LAS bf16x8*)(lds + (BUF) * NA_TBYTES + (kc0 + 16 * hf + li) * NA_TSTRIDE + (32 * ks + 8 * g) * 2); \
                a_ = __builtin_amdgcn_mfma_f32_16x16x32_bf16(kf_, qf[ks], a_, 0, 0, 0); } \
            _Pragma("unroll") for (int j = 0; j < 4; ++j) { const float s_ = okv[hf][j] ? a_[j] * QSCALE : NEGF; a_[j] = s_; mx = fmaxf(mx, s_); } \
            sT[2 * (I) + hf] = a_; } } while (0)
#pragma unroll
    for (int j = 0; j < 9; ++j) {
        if (j < nrows) {
            *(LAS v4u*)(wdst + (j & 1) * NA_TBYTES) = sq[j % NA_PF][0]; *(LAS v4u*)(wdst + (j & 1) * NA_TBYTES + 32 * NA_TSTRIDE) = sq[j % NA_PF][1];
            if (j + NA_PF < nrows) { sq[j % NA_PF][0] = *(const v4u*)(kst + (size_t)((j + NA_PF) * 64) * NPJ); sq[j % NA_PF][1] = *(const v4u*)(kst + (size_t)((j + NA_PF) * 64 + 32) * NPJ); }
            asm volatile("s_waitcnt lgkmcnt(0)" ::: "memory"); __builtin_amdgcn_s_barrier(); asm volatile("" ::: "memory");
            if (shift == 0) { if (j < 8) NA_SROW(j, j & 1); }
            else { if (j >= 1) NA_SROW(j - 1, j & 1); }
        }
    }
#undef NA_SROW
#pragma unroll
    for (int j = 0; j < NA_PF; ++j) { sq[j][0] = *(const v4u*)(vst + (size_t)(j * 64) * NPJ); sq[j][1] = *(const v4u*)(vst + (size_t)(j * 64 + 32) * NPJ); }
    mx = fmaxf(mx, __shfl_xor(mx, 16)); mx = fmaxf(mx, __shfl_xor(mx, 32));
    float sum = 0.f;
#pragma unroll
    for (int kt = 0; kt < 16; ++kt)
#pragma unroll
        for (int j = 0; j < 4; ++j) { const float p = exp_f(sT[kt][j] - mx); sT[kt][j] = p; sum += p; }
    sum += __shfl_xor(sum, 16); sum += __shfl_xor(sum, 32);
    f32x4 O[8];
#pragma unroll
    for (int et = 0; et < 8; ++et) O[et] = (f32x4){0.f, 0.f, 0.f, 0.f};
    __syncthreads();
#define NA_VROW(I, BUF) do { const v4u pw_ = {pk2(sT[2 * (I)][0], sT[2 * (I)][1]), pk2(sT[2 * (I)][2], sT[2 * (I)][3]), pk2(sT[2 * (I) + 1][0], sT[2 * (I) + 1][1]), pk2(sT[2 * (I) + 1][2], sT[2 * (I) + 1][3])}; \
        const bf16x8 pf_ = __builtin_bit_cast(bf16x8, pw_); \
        _Pragma("unroll") for (int et = 0; et < 8; ++et) { const bf16x8 vf_ = tr_frag16p(lds + (BUF) * NA_TBYTES, NA_TSTRIDE, kc0, 16 * et, lane); \
            O[et] = __builtin_amdgcn_mfma_f32_16x16x32_bf16(vf_, pf_, O[et], 0, 0, 0); } } while (0)
#pragma unroll
    for (int j = 0; j < 9; ++j) {
        if (j < nrows) {
            *(LAS v4u*)(wdst + (j & 1) * NA_TBYTES) = sq[j % NA_PF][0]; *(LAS v4u*)(wdst + (j & 1) * NA_TBYTES + 32 * NA_TSTRIDE) = sq[j % NA_PF][1];
            if (j + NA_PF < nrows) { sq[j % NA_PF][0] = *(const v4u*)(vst + (size_t)((j + NA_PF) * 64) * NPJ); sq[j % NA_PF][1] = *(const v4u*)(vst + (size_t)((j + NA_PF) * 64 + 32) * NPJ); }
            asm volatile("s_waitcnt lgkmcnt(0)" ::: "memory"); __builtin_amdgcn_s_barrier(); asm volatile("" ::: "memory");
            if (shift == 0) { if (j < 8) NA_VROW(j, j & 1); }
            else { if (j >= 1) NA_VROW(j - 1, j & 1); }
        }
    }
#undef NA_VROW
    const float rl = 1.0f / sum;
    bf16* op = (bf16*)(P.ws + WS_XN) + qrow * D + 512 + head * 128 + 4 * g;
#pragma unroll
    for (int et = 0; et < 8; ++et) { const f32x4 y = O[et] * rl; *(v2u*)(op + 16 * et) = (v2u){pk2(y[0], y[1]), pk2(y[2], y[3])}; }
    __syncthreads();
}

__device__ __forceinline__ void gate_unit(const Params& P, int l, int item, LAS unsigned char* lds, const unsigned* rowsq, int wv) {
    const int tid = tid_fresh(wv), lane = tid & 63, wave = tid >> 6, g = lane >> 4, li = lane & 15, rt = wave & 3, kh = wave >> 2;
    const bf16* A = (const bf16*)(P.ws + WS_XN) + (size_t)(item * 64 + rt * 16 + li) * D + kh * 1024 + 8 * g;
    const bf16* B = (const bf16*)(P.ws + WS_WIN) + (size_t)(NPJ + li) * D + kh * 1024 + 8 * g;
    f32x4 acc = {0.f, 0.f, 0.f, 0.f};
#pragma unroll 1
    for (int k0 = 0; k0 < 32; k0 += 8) {
        bf16x8 a[8], b[8];
#pragma unroll
        for (int i = 0; i < 8; ++i) { a[i] = *(const bf16x8*)(A + 32 * (k0 + i)); b[i] = *(const bf16x8*)(B + 32 * (k0 + i)); }
#pragma unroll
        for (int i = 0; i < 8; ++i) acc = __builtin_amdgcn_mfma_f32_16x16x32_bf16(a[i], b[i], acc, 0, 0, 0);
    }
    LAS f32x4* xb = (LAS f32x4*)lds + rt * 64 + lane;
    if (kh == 1) *xb = acc;
    __syncthreads();
    if (kh == 0) { const f32x4 o = *xb; float* gp = (float*)(P.ws + WS_GATES) + (size_t)(item * 64 + rt * 16 + 4 * g) * 16 + li;
#pragma unroll
        for (int j = 0; j < 4; ++j) { const float rs = rsqrtf((float)rowsq[item * 64 + rt * 16 + 4 * g + j] * (1.0f / (2048.0f * 4096.0f)) + 1e-6f); gp[j * 16] = (acc[j] + o[j]) * rs; } }
    __syncthreads();
}
__device__ __forceinline__ void scan_phase(const Params& P, int l, int wv) {
    const int gt = blockIdx.x * 512 + tid_fresh(wv), GT = GRID * 512;
    const bf16* cl = (const bf16*)(P.ws + WS_CLOC); bf16* cs = (bf16*)(P.ws + WS_CST);
    const float* mloc = (const float*)(P.ws + WS_MLOC); const float* gtot = (const float*)(P.ws + WS_GTOT);
#pragma unroll 1
    for (int v = gt; v < 128 * 4096 + 64 * 32; v += GT) {
        const bool isn = v >= 128 * 4096;
        const int chain = isn ? (v - 128 * 4096) >> 5 : v >> 12, e4 = isn ? (v - 128 * 4096) & 31 : v & 4095;
        const int typ = chain >> 6, dir = chain & 1, h = (chain >> 1) & 3;
        float dec_r = 0.f; if (typ) dec_r = __builtin_amdgcn_exp2f(128.f * ret_log2g(P, l, dir, h));
        float zz = 0.f; asm volatile("" : "+v"(zz));
        f32x4 st = {zz, zz, zz, zz}; float m = NEGF;
        f32x4 lcv[16];
#pragma unroll
        for (int k = 0; k < 16; ++k) { const int oc = dir ? 15 - k : k; const size_t idx = (size_t)chain * 16 + oc;
            if (isn) lcv[k] = *(const f32x4*)((const float*)(P.ws + WS_NLOC) + idx * 128 + 4 * e4);
            else { const v2u w = *(const v2u*)(cl + idx * 16384 + 4 * e4); lcv[k] = (f32x4){lo2f(w.x), hi2f(w.x), lo2f(w.y), hi2f(w.y)}; } }
#pragma unroll
        for (int k = 0; k < 16; ++k) {
            const int oc = dir ? 15 - k : k; const size_t idx = (size_t)chain * 16 + oc;
            float dec, scl;
            if (typ) { dec = dec_r; scl = 1.f; }
            else { const float gg = gtot[idx], ml = mloc[idx], mn = fmaxf(gg + m, ml); dec = exp_f(gg + m - mn); scl = exp_f(ml - mn);
                if (isn && e4 == 0) ((float*)(P.ws + WS_MST))[idx] = m;
                m = mn; }
            if (isn) { float* ns = (float*)(P.ws + WS_NST) + idx * 128 + 4 * e4; *(f32x4*)ns = st; }
            else { *(v2u*)(cs + idx * 16384 + 4 * e4) = (v2u){pk2(st.x, st.y), pk2(st.z, st.w)}; }
            st = st * dec + lcv[k] * scl;
        }
    }
}
typedef __attribute__((address_space(1))) unsigned gu32;
#define XB_TMO      128
#define XB_XCNT(j)  (256  + 64 * (j))
#define XB_XSUB(j)  (1280 + 64 * (j))
#define XB_XGEN(j)  (2304 + 64 * (j))
#define XB_TOP      3328
#define XB_TOPGEN   3392
#define XCD_BAR_WORDS 3456
#define XB_SPIN_CAP (1u << 18)

__device__ __forceinline__ unsigned xb_ld(unsigned* p)              { return __hip_atomic_load(p, __ATOMIC_RELAXED, __HIP_MEMORY_SCOPE_AGENT); }
__device__ __forceinline__ unsigned xb_add(unsigned* p, unsigned v) { return __hip_atomic_fetch_add(p, v, __ATOMIC_RELAXED, __HIP_MEMORY_SCOPE_AGENT); }
__device__ __forceinline__ unsigned xb_xcc_id() { return (unsigned)__builtin_amdgcn_s_getreg((3 << 11) | 20) & 0xFu; }
#define XB_SPIN(cond, bar) do { unsigned _sp = 0; while (cond) { __builtin_amdgcn_s_sleep(1); \
    if ((++_sp & 255u) == 0u) { if (xb_ld(&(bar)[XB_TMO])) break; if (_sp > XB_SPIN_CAP) { atomicAdd(&(bar)[XB_TMO], 1u); break; } } } } while (0)

struct XcdBarrier {
    unsigned* bar; unsigned x;
    volatile LAS unsigned* st;
};

__device__ __forceinline__ XcdBarrier xcd_barrier_post(unsigned* bar, volatile LAS unsigned* st, int wv) {
    XcdBarrier b; b.bar = bar; b.x = xb_xcc_id(); b.st = st;
    if (wv == 0 && __builtin_amdgcn_mbcnt_hi(~0u, __builtin_amdgcn_mbcnt_lo(~0u, 0u)) == 0u) (void)xb_add(&bar[XB_XCNT(b.x)], 1u);
    return b;
}
__device__ __forceinline__ void xcd_barrier_complete(unsigned* bar, unsigned x, unsigned& nloc, unsigned& nx) {
    const unsigned G = gridDim.x * gridDim.y * gridDim.z;
    unsigned sum, cnt, mine, sp = 0u;
    for (;;) {
        sum = 0u; cnt = 0u; mine = 0u;
#pragma unroll
        for (unsigned j = 0; j < 16; ++j) { const unsigned c = xb_ld(&bar[XB_XCNT(j)]); sum += c; cnt += (c > 0u) ? 1u : 0u; mine = (j == x) ? c : mine; }
        if (sum == G) break;
        __builtin_amdgcn_s_sleep(1);
        if ((++sp & 255u) == 0u) { if (xb_ld(&bar[XB_TMO])) break; if (sp > XB_SPIN_CAP) { atomicAdd(&bar[XB_TMO], 1u); break; } }
    }
    nloc = mine > 0u ? mine : 1u; nx = cnt > 0u ? cnt : 1u;
}

__device__ __forceinline__ void xcd_barrier(const XcdBarrier& b, int wv) {
    asm volatile("s_waitcnt vmcnt(0)" ::: "memory");
    __syncthreads();
    if (wv == 0 && __builtin_amdgcn_mbcnt_hi(~0u, __builtin_amdgcn_mbcnt_lo(~0u, 0u)) == 0u) {
        unsigned* bar = b.bar;
        __builtin_amdgcn_s_waitcnt(0);
        unsigned nloc = b.st[0], nx = b.st[1];
        if (nloc == 0u) { xcd_barrier_complete(bar, b.x, nloc, nx); b.st[0] = nloc; b.st[1] = nx; }
        const unsigned old = xb_add(&bar[XB_XSUB(b.x)], 1u);
        const unsigned gen = old / nloc;
        if (old + 1u == (gen + 1u) * nloc) {
            __builtin_amdgcn_fence(__ATOMIC_RELEASE, "agent");
            asm volatile("s_waitcnt vmcnt(0)" ::: "memory");
            const unsigned og = xb_add(&bar[XB_TOP], 1u);
            const unsigned tg = og / nx;
            if (og + 1u == (tg + 1u) * nx) xb_add(&bar[XB_TOPGEN], 1u);
            else XB_SPIN(xb_ld(&bar[XB_TOPGEN]) == tg, bar);
            __builtin_amdgcn_fence(__ATOMIC_ACQUIRE, "agent");
            xb_add(&bar[XB_XGEN(b.x)], 1u);
            asm volatile("s_waitcnt vmcnt(0)" ::: "memory");
        } else {
            XB_SPIN(xb_ld(&bar[XB_XGEN(b.x)]) == gen, bar);
            __builtin_amdgcn_fence(__ATOMIC_ACQUIRE, "agent");
            asm volatile("s_waitcnt vmcnt(0)" ::: "memory");
        }
    }
    __syncthreads();
}
__device__ __forceinline__ void fill_rstd_table(LAS float* tab, const unsigned* rowsq, int bid, int wv) {
    const int tid = tid_fresh(wv);
#pragma unroll
    for (int i = 0; i < 4; ++i) { const int r = tid + 512 * i; tab[r] = rsqrtf((float)rowsq[(bid & 7) * 2048 + r] * (1.0f / (2048.0f * 4096.0f)) + EPS); }
    __syncthreads();
}
__global__ void __launch_bounds__(512, 2) fwd_kernel(Params P) {
    extern __shared__ __attribute__((aligned(16))) unsigned char lds_raw[];
    LAS unsigned char* lds = (LAS unsigned char*)lds_raw;
    cg::grid_group grid = cg::this_grid();
    const int wv = __builtin_amdgcn_readfirstlane(threadIdx.x >> 6);
    { volatile LAS unsigned* misc = (volatile LAS unsigned*)(lds + MISC_OFF); if (threadIdx.x < 32) misc[threadIdx.x] = 0u;
      if (blockIdx.x == 0) for (int i = threadIdx.x; i < 4096; i += 512) ((unsigned*)P.ws)[i] = 0u; }
    __syncthreads();
    grid.sync();
    const XcdBarrier bar = xcd_barrier_post((unsigned*)P.ws, (volatile LAS unsigned*)(lds + MISC_OFF) + 8, wv);
#define GRID_SYNC() xcd_barrier(bar, wv)
    const int G = GRID, bid = blockIdx.x;
    bf16* xn = (bf16*)(P.ws + WS_XN); bf16* proj = (bf16*)(P.ws + WS_PROJ); bf16* hidden = proj;
    bf16* wgu = (bf16*)(P.ws + WS_WGU); bf16* wdn = (bf16*)(P.ws + WS_WDN); bf16* win = (bf16*)(P.ws + WS_WIN); bf16* wout = (bf16*)(P.ws + WS_WOUT);
    bf16* xnb = (bf16*)(P.ws + WS_CLOC);
    unsigned* rowsq = (unsigned*)(P.ws + WS_ROWSQ);
#pragma unroll 1
    for (int l = 0; l < 2; ++l) {
#if !defined(PH) || (PH & 1)
        convert_weights(P, l, lds, wv);
#endif
        if (l == 0) {
            cast_rows_bf16(P.in[I_X], xn, rowsq, wv);
            unsigned zlo = 0u; asm volatile("" : "+v"(zlo));
#pragma unroll 1
            for (int i = bid * 512 + tid_fresh(wv); i < 8 * M; i += G * 512) __hip_atomic_store(rowsq + M + i, zlo, __ATOMIC_RELAXED, __HIP_MEMORY_SCOPE_AGENT);
        }
        GRID_SYNC();
#pragma unroll 1
        for (int f = 0; f < 2; ++f) {
            if (f == 1) {
#if !defined(PH) || (PH & 128)
                gate_unit(P, l, bid, lds, rowsq + (size_t)(4 * l + 1) * M, wv);
                { pg8::Gemm g{xn, win, M, NPJ, D}; pg8::StaticOrder S; S.init(M, NPJ, G, bid, 4); fill_rstd_table((LAS float*)(lds + 131072), rowsq + (size_t)(4 * l + 1) * M, bid, wv); pg8::EpiProj E{proj, NPJ, (const LAS float*)(lds + 131072)};
                  pg8::gemm_phase<pg8::EpiProj, pg8::StaticOrder, true, true>(lds, g, S, E, wv); }
#endif
                GRID_SYNC();
                prep_phase(P, l, wv);
#pragma unroll 1
                for (int u = (bid & 7) * 32 + (bid >> 3); u < 1024; u += G) {
#if !defined(PH) || (PH & 8)
                    na_block_unit(P, l, u, lds, wv);
#endif
                }
                GRID_SYNC();
#pragma unroll 1
                for (int k4 = 0; k4 < 4; ++k4) { const int u = (k4 >> 1) * 512 + (bid & 7) * 64 + (bid >> 3) + 32 * (k4 & 1);
#if !defined(PH) || (PH & 2)
                    if (u < 512) lin_local_unit<false>(P, l, u >> 6, (u >> 4) & 3, u & 15, lds, wv);
#endif
#if !defined(PH) || (PH & 4)
                    if (u >= 512) lin_local_unit<true>(P, l, (u - 512) >> 6, (u >> 4) & 3, u & 15, lds, wv);
#endif
                }
                GRID_SYNC();
#if !defined(PH) || (PH & 16)
                scan_phase(P, l, wv);
#endif
                GRID_SYNC();
#pragma unroll 1
                for (int k4 = 0; k4 < 4; ++k4) { const int u = (k4 >> 1) * 512 + (bid & 7) * 64 + (bid >> 3) + 32 * (k4 & 1);
#if !defined(PH) || (PH & 32)
                    if (u < 512) lin_out_unit<false>(P, l, u >> 6, (u >> 4) & 3, u & 15, lds, wv);
#endif
#if !defined(PH) || (PH & 64)
                    if (u >= 512) lin_out_unit<true>(P, l, (u - 512) >> 6, (u >> 4) & 3, u & 15, lds, wv);
#endif
                }
                GRID_SYNC();
#if !defined(PH) || (PH & 256)
                { pg8::Gemm g{xn, wout, M, D, D}; pg8::StaticOrder S; S.init(M, D, G, bid, 4); pg8::EpiResid E{P.out, P.out, xnb, rowsq + (size_t)(4 * l + 2) * M, D, 1.0f};
                  pg8::gemm_phase<pg8::EpiResid, pg8::StaticOrder, true, true>(lds, g, S, E, wv); }
#endif
                GRID_SYNC();
            }
#if !defined(PH) || (PH & 512)
            { pg8::Gemm g{f ? xnb : xn, wgu + (size_t)f * NGU * D, M, NGU, D}; pg8::StaticOrder S; S.init(M, NGU, G, bid, 4); fill_rstd_table((LAS float*)(lds + 131072), rowsq + (size_t)(4 * l + 2 * f) * M, bid, wv); pg8::EpiSwiGLU E{hidden, FF, (const LAS float*)(lds + 131072)};
              pg8::gemm_phase<pg8::EpiSwiGLU, pg8::StaticOrder, true, true>(lds, g, S, E, wv); }
#endif
            GRID_SYNC();
#if !defined(PH) || (PH & 1024)
            { pg8::Gemm g{hidden, wdn + (size_t)f * D * FF, M, D, FF}; pg8::StaticOrder S; S.init(M, D, G, bid, 4, 1);
              pg8::EpiResid E{(l == 0 && f == 0) ? P.in[I_X] : P.out, P.out, xn, rowsq + (size_t)(4 * l + (f ? 4 : 1)) * M, D, 0.5f};
              pg8::gemm_phase<pg8::EpiResid, pg8::StaticOrder, true, true>(lds, g, S, E, wv); }
#endif
            GRID_SYNC();
        }
    }
    rms_rows_f32(P.out, P.in[I_FINN], P.out, wv);
}

extern "C" void kernel_launch(void* const* d_in, const int* in_sizes, int n_in, void* d_out, int out_size, void* d_ws, size_t ws_size, hipStream_t stream) {
    static int grid = 0;
    if (grid == 0) {
        if (n_in != 18 || in_sizes[0] != M * D || out_size != M * D || ws_size < WS_END) {
            fprintf(stderr, "kernel_launch: unexpected shapes: n_in %d in0 %d out %d ws %zu (need %zu)\n", n_in, n_in > 0 ? in_sizes[0] : -1, out_size, ws_size, (size_t)WS_END); grid = -1; return; }
        int dev = 0, cus = 0, per_cu = 0;
        (void)hipGetDevice(&dev); (void)hipDeviceGetAttribute(&cus, hipDeviceAttributeMultiprocessorCount, dev);
        (void)hipFuncSetAttribute((const void*)fwd_kernel, hipFuncAttributeMaxDynamicSharedMemorySize, LDS_BYTES);
        (void)hipOccupancyMaxActiveBlocksPerMultiprocessor(&per_cu, (const void*)fwd_kernel, 512, LDS_BYTES);
        if (per_cu < 1) per_cu = 1;
        grid = cus * per_cu;
        if (grid < GRID) { fprintf(stderr, "kernel_launch: this kernel needs %d co-resident workgroups, the device holds %d\n", GRID, grid); grid = -1; return; }
        grid = GRID;
        fprintf(stderr, "kernel_launch: grid %d (cus %d x %d), ws %zu\n", grid, cus, per_cu, ws_size);
    }
    if (grid < 0) return;
    Params p{};
    for (int i = 0; i < 18; ++i) p.in[i] = (const float*)d_in[i];
    p.out = (float*)d_out; p.ws = (unsigned char*)d_ws;
    void* args[] = {&p};
    hipError_t e = hipLaunchCooperativeKernel((const void*)fwd_kernel, dim3(grid), dim3(512), args, LDS_BYTES, stream);
    if (e != hipSuccess) fprintf(stderr, "kernel_launch: cooperative launch failed: %s (grid %d)\n", hipGetErrorString(e), grid);
}
```

```cpp
#include <hip/hip_runtime.h>
#include <hip/hip_cooperative_groups.h>
#include <cstdio>
#include <cstdint>
namespace cg = cooperative_groups;
__device__ __forceinline__ int tid_fresh(int wv) { int t; asm volatile("v_mbcnt_lo_u32_b32 %0, -1, 0\n\tv_mbcnt_hi_u32_b32 %0, -1, %0" : "=v"(t)); return wv * 64 + t; }
namespace pg8 {
#define PG8_LAS __attribute__((address_space(3)))
typedef unsigned short bf16_t;
typedef short bf16x8 __attribute__((ext_vector_type(8)));
typedef float f32x4 __attribute__((ext_vector_type(4)));
typedef unsigned u32x4 __attribute__((ext_vector_type(4)));
constexpr int BM = 256, BK = 64, HALF = 128, HTB = HALF * BK * 2  , STAGE_BYTES = 8 * HTB, NXCD = 8, WGM = 8;

__host__ __device__ __forceinline__ int lds_byte(int r, int c) { const int st = (r >> 4) * 2 + (c >> 5), rr = r & 15, cc = c & 31, ob = rr * 64 + cc * 2; return st * 1024 + (ob ^ (((ob >> 9) & 1) << 5)); }
__host__ __device__ __forceinline__ void stage_rc(int b, int& R, int& C) { const int st = b / 1024, sb = b % 1024, swz = sb ^ (((sb >> 9) & 1) << 5); R = (st >> 1) * 16 + swz / 64; C = (st & 1) * 32 + (swz % 64) / 2; }
__host__ __device__ __forceinline__ int perm32(int rho) { const int n = rho >> 4, i = rho & 15; return 8 * (i >> 2) + 4 * n + (i & 3); }

struct Unit { int pm, pn; };
struct Gemm { const bf16_t* A; const bf16_t* Bt; int M, N, K; };

struct StaticOrder {
    int nM, nN, nwg, G, c, wgm, flip;
    __host__ __device__ void init(int M, int N, int G_, int c_, int wgm_ = WGM, int flip_ = 0) { nM = M / BM; nN = N / BM; nwg = nM * nN; G = G_; c = c_; wgm = wgm_; flip = flip_; }
    __host__ __device__ bool next(int i, Unit& u) const {
        const int R = (nwg + G - 1) / G; if (i >= R) return false; const long L = (long)(flip ? R - 1 - i : i) * G + c; if (L >= nwg) return false;
        int wgid = (int)L; { const int q = nwg / NXCD, r = nwg % NXCD, xcd = wgid % NXCD, off = wgid / NXCD; wgid = (xcd < r ? xcd * (q + 1) : r * (q + 1) + (xcd - r) * q) + off; }
        const int nig = wgm * nN, gid = wgid / nig, fm = gid * wgm, gsz = (nM - fm) < wgm ? (nM - fm) : wgm;
        u.pm = fm + ((wgid % nig) % gsz); u.pn = (wgid % nig) / gsz; return true;
    }
    __device__ __forceinline__ void a_ready(const Unit&) const {}
    __device__ __forceinline__ void done(const Unit&) const {}
};

typedef float f32x2 __attribute__((ext_vector_type(2))); typedef __bf16 bf16x2_t __attribute__((ext_vector_type(2)));
__device__ __forceinline__ unsigned cvt_pk_bf16(float lo, float hi) { f32x2 v = {lo, hi}; bf16x2_t b = __builtin_convertvector(v, bf16x2_t); return __builtin_bit_cast(unsigned, b); }
__device__ __forceinline__ float silu_f(float x) { return x * __builtin_amdgcn_rcpf(1.0f + __builtin_amdgcn_exp2f(-1.4426950408889634f * x)); }
struct EpiSwiGLU {
    static constexpr bool PERM = true, AFTER_DRAIN = false;
    struct Pre {};
    __device__ __forceinline__ Pre prefetch(const Unit&, int, int) const { return Pre{}; }
    bf16_t* O; int ldc; const __attribute__((address_space(3))) float* rstab;
    __device__ __forceinline__ void operator()(const f32x4 (&acc)[2][2][4][2], const Unit& u, int wr, int wc, int fr, int fq, const Pre& pre) const {
        const int row0 = u.pm * BM + wr * 64 + fr, col0 = u.pn * HALF + wc * 32 + 8 * fq;
        float rs[2][4];
#pragma unroll
        for (int ai = 0; ai < 2; ++ai)
#pragma unroll
            for (int m = 0; m < 4; ++m) rs[ai][m] = rstab[(u.pm & 7) * BM + wr * 64 + fr + ai * HALF + m * 16];
#pragma unroll
        for (int ai = 0; ai < 2; ++ai)
#pragma unroll
            for (int m = 0; m < 4; ++m) { bf16_t* rowp = O + (size_t)(row0 + ai * HALF + m * 16) * ldc + col0;
                const f32x4 g0 = acc[ai][0][m][0] * rs[ai][m], g1 = acc[ai][0][m][1] * rs[ai][m], u0 = acc[ai][1][m][0] * rs[ai][m], u1 = acc[ai][1][m][1] * rs[ai][m];
                u32x4 w; w.x = cvt_pk_bf16(silu_f(g0[0]) * u0[0], silu_f(g0[1]) * u0[1]); w.y = cvt_pk_bf16(silu_f(g0[2]) * u0[2], silu_f(g0[3]) * u0[3]);
                w.z = cvt_pk_bf16(silu_f(g1[0]) * u1[0], silu_f(g1[1]) * u1[1]); w.w = cvt_pk_bf16(silu_f(g1[2]) * u1[2], silu_f(g1[3]) * u1[3]);
                *(u32x4*)rowp = w; }
    }
};
struct EpiResid {
    static constexpr bool PERM = false, AFTER_DRAIN = false;
    struct Pre {};
    __device__ __forceinline__ Pre prefetch(const Unit&, int, int) const { return Pre{}; }
    const float* base; float* out; bf16_t* hb; unsigned* rowsq; int ldc; float scale;
    __device__ __forceinline__ void operator()(const f32x4 (&acc)[2][2][4][2], const Unit& u, int wr, int wc, int fr, int fq, const Pre&) const {
        typedef unsigned u32x2 __attribute__((ext_vector_type(2)));
        const int row0 = u.pm * BM + wr * 64 + fr, col0 = u.pn * BM + wc * 32 + 4 * fq;
        float ssv[2][4];
#pragma unroll
        for (int ai = 0; ai < 2; ++ai) {
            f32x4 bs[4][2][2];
#pragma unroll
            for (int m = 0; m < 4; ++m) { const unsigned off = (unsigned)(row0 + ai * HALF + m * 16) * (unsigned)ldc + (unsigned)col0;
#pragma unroll
                for (int bj = 0; bj < 2; ++bj)
#pragma unroll
                    for (int n = 0; n < 2; ++n) bs[m][bj][n] = *(const f32x4*)(base + off + bj * HALF + n * 16); }
            asm volatile("" ::: "memory");
#pragma unroll
            for (int m = 0; m < 4; ++m) { const unsigned off = (unsigned)(row0 + ai * HALF + m * 16) * (unsigned)ldc + (unsigned)col0; float ss = 0.f;
#pragma unroll
                for (int bj = 0; bj < 2; ++bj)
#pragma unroll
                    for (int n = 0; n < 2; ++n) { const f32x4 v = bs[m][bj][n] + acc[ai][bj][m][n] * scale;
                        *(f32x4*)(out + off + bj * HALF + n * 16) = v; *(u32x2*)(hb + off + bj * HALF + n * 16) = (u32x2){cvt_pk_bf16(v[0], v[1]), cvt_pk_bf16(v[2], v[3])};
                        ss += (v[0] * v[0] + v[1] * v[1]) + (v[2] * v[2] + v[3] * v[3]); }
                ssv[ai][m] = ss; }
            asm volatile("" ::: "memory");
        }
#pragma unroll
        for (int ai = 0; ai < 2; ++ai)
#pragma unroll
            for (int m = 0; m < 4; ++m) { float ss = ssv[ai][m]; ss += __shfl_xor(ss, 16); ss += __shfl_xor(ss, 32);
                if (fq == 0) (void)__hip_atomic_fetch_add(rowsq + row0 + ai * HALF + m * 16, (unsigned)(ss * 4096.0f + 0.5f), __ATOMIC_RELAXED, __HIP_MEMORY_SCOPE_AGENT); }
    }
};
struct EpiProj {
    static constexpr bool PERM = true, AFTER_DRAIN = false;
    struct Pre {};
    __device__ __forceinline__ Pre prefetch(const Unit&, int, int) const { return Pre{}; }
    bf16_t* O; int ldc; const __attribute__((address_space(3))) float* rstab;
    __device__ __forceinline__ void operator()(const f32x4 (&acc)[2][2][4][2], const Unit& u, int wr, int wc, int fr, int fq, const Pre& pre) const {
        const int row0 = u.pm * BM + wr * 64 + fr, col0 = u.pn * BM + wc * 32 + 8 * fq;
#pragma unroll
        for (int ai = 0; ai < 2; ++ai)
#pragma unroll
            for (int m = 0; m < 4; ++m) { bf16_t* rowp = O + (size_t)(row0 + ai * HALF + m * 16) * ldc + col0;
                const float rs = rstab[(u.pm & 7) * BM + wr * 64 + fr + ai * HALF + m * 16];
#pragma unroll
                for (int bj = 0; bj < 2; ++bj) { const f32x4 v0 = acc[ai][bj][m][0] * rs, v1 = acc[ai][bj][m][1] * rs;
                    u32x4 w; w.x = cvt_pk_bf16(v0[0], v0[1]); w.y = cvt_pk_bf16(v0[2], v0[3]); w.z = cvt_pk_bf16(v1[0], v1[1]); w.w = cvt_pk_bf16(v1[2], v1[3]);
                    *(u32x4*)(rowp + bj * HALF) = w; } }
    }
};
template <class Epi, class Sched, bool ALIGN_EPI = false, bool SP2 = false>
__device__ __forceinline__ void gemm_phase(PG8_LAS unsigned char* lds, const Gemm g, const Sched S, const Epi E, int wv) {
    const int tid = tid_fresh(wv), wid = __builtin_amdgcn_readfirstlane(tid >> 6), lane = tid & 63, wr = wid >> 2, wc = wid & 3, fr = lane & 15, fq = lane >> 4;
    const int K = g.K, nt = K / BK;
    unsigned voffA[2], voffB[2];
#pragma unroll
    for (int i = 0; i < 2; ++i) { int R, C; stage_rc(tid * 16 + i * 8192, R, C); const int Rb = Epi::PERM ? ((R & ~31) + perm32(R & 31)) : R;
        voffA[i] = (unsigned)(R * K + C) * 2u; voffB[i] = (unsigned)(Rb * K + C) * 2u; }
    const size_t kstep = (size_t)(BK * 2);
    const size_t hstep = (size_t)HALF * K * 2;
    const size_t tstep = 2 * hstep;
    const unsigned ldsw = (unsigned)wid * 1024u;
    const int aoff = lds_byte(wr * 64 + fr, fq * 8), boff = lds_byte(wc * 32 + fr, fq * 8);
#define PG8_SA(b, h) (((b) * 2 + (h)) * HTB)
#define PG8_SB(b, h) ((4 + (b) * 2 + (h)) * HTB)
#define PG8_STAGE(bufoff, gbase, voff) do { _Pragma("unroll") for (int _i = 0; _i < 2; ++_i) \
        __builtin_amdgcn_global_load_lds((const unsigned*)((const char*)(gbase) + (voff)[_i]), (PG8_LAS unsigned*)(lds + (bufoff) + ldsw + _i * 8192), 16, 0, 0); } while (0)
#define PG8_LDA(dst, b, h) do { _Pragma("unroll") for (int m = 0; m < 4; ++m) _Pragma("unroll") for (int k = 0; k < 2; ++k) dst[m][k] = *(const PG8_LAS bf16x8*)(lds + PG8_SA(b, h) + aoff + m * 2048 + k * 1024); } while (0)
#define PG8_LDB(dst, b, h) do { _Pragma("unroll") for (int n = 0; n < 2; ++n) _Pragma("unroll") for (int k = 0; k < 2; ++k) dst[n][k] = *(const PG8_LAS bf16x8*)(lds + PG8_SB(b, h) + boff + n * 2048 + k * 1024); } while (0)
#define PG8_MMA(ai, bj, At, Bt) do { __builtin_amdgcn_s_setprio(1); _Pragma("unroll") for (int m = 0; m < 4; ++m) _Pragma("unroll") for (int n = 0; n < 2; ++n) _Pragma("unroll") for (int k = 0; k < 2; ++k) \
        acc[ai][bj][m][n] = __builtin_amdgcn_mfma_f32_16x16x32_bf16(Bt[n][k], At[m][k], acc[ai][bj][m][n], 0, 0, 0); __builtin_amdgcn_s_setprio(0); } while (0)
#define PG8_WAIT_V(n) asm volatile("s_waitcnt vmcnt(" #n ")" ::: "memory")
#define PG8_WAIT_L(n) asm volatile("s_waitcnt lgkmcnt(" #n ")" ::: "memory")
#define PG8_BAR __builtin_amdgcn_s_barrier()
#define PG8_SCHED __builtin_amdgcn_sched_barrier(0)
    Unit cur, nxt; int ui = 0;
    if (!S.next(0, cur)) return;
    f32x4 acc[2][2][4][2];
#pragma unroll
    for (int a = 0; a < 2; ++a)
#pragma unroll
        for (int b = 0; b < 2; ++b)
#pragma unroll
            for (int m = 0; m < 4; ++m)
#pragma unroll
                for (int n = 0; n < 2; ++n) acc[a][b][m][n] = (f32x4){0.f, 0.f, 0.f, 0.f};
    bf16x8 At[4][2], B0[2][2], B1[2][2];
    const char* cA = (const char*)g.A + (size_t)cur.pm * tstep; const char* cB = (const char*)g.Bt + (size_t)cur.pn * tstep;
    S.a_ready(cur);
    typename Epi::Pre pre = E.prefetch(cur, wr, fr);
    if constexpr (SP2) {
        PG8_STAGE(PG8_SB(0, 0), cB, voffB); PG8_STAGE(PG8_SB(0, 1), cB + hstep, voffB); PG8_STAGE(PG8_SA(0, 0), cA, voffA); PG8_STAGE(PG8_SA(0, 1), cA + hstep, voffA);
        if (wr == 1) PG8_BAR;
        PG8_WAIT_V(2); PG8_BAR;
        PG8_STAGE(PG8_SB(1, 0), cB + kstep, voffB); PG8_STAGE(PG8_SA(1, 0), cA + kstep, voffA); PG8_STAGE(PG8_SB(1, 1), cB + hstep + kstep, voffB);
        PG8_WAIT_V(6); PG8_BAR;
    } else {
        PG8_STAGE(PG8_SB(0, 0), cB, voffB); PG8_STAGE(PG8_SA(0, 0), cA, voffA); PG8_STAGE(PG8_SB(0, 1), cB + hstep, voffB); PG8_STAGE(PG8_SA(0, 1), cA + hstep, voffA);
        if (wr == 1) PG8_BAR;
        PG8_WAIT_V(4); PG8_BAR;
        PG8_STAGE(PG8_SB(1, 0), cB + kstep, voffB); PG8_STAGE(PG8_SA(1, 0), cA + kstep, voffA); PG8_STAGE(PG8_SB(1, 1), cB + hstep + kstep, voffB);
        PG8_WAIT_V(6); PG8_BAR;
    }
    for (;;) {
        const bool has_next = S.next(ui + 1, nxt);
        const char* nA = has_next ? (const char*)g.A + (size_t)nxt.pm * tstep : cA; const char* nB = has_next ? (const char*)g.Bt + (size_t)nxt.pn * tstep : cB;
        for (int t = 0; t < nt; t += 2) {
            const bool last = (t == nt - 2);
            const char* a1 = cA + (size_t)(t + 1) * kstep;
            const char* a2 = last ? nA : cA + (size_t)(t + 2) * kstep; const char* b2 = last ? nB : cB + (size_t)(t + 2) * kstep;
            const char* a3 = a2 + kstep; const char* b3 = b2 + kstep;
            if (last && has_next) S.a_ready(nxt);
            if constexpr (SP2) {
            PG8_LDB(B0, 0, 0); PG8_LDB(B1, 0, 1); PG8_SCHED; PG8_LDA(At, 0, 0); PG8_STAGE(PG8_SA(1, 1), a1 + hstep, voffA);
            PG8_WAIT_V(8); PG8_WAIT_L(0); PG8_BAR; PG8_MMA(0, 0, At, B0); PG8_MMA(0, 1, At, B1); PG8_BAR; PG8_SCHED;
            PG8_LDA(At, 0, 1); PG8_STAGE(PG8_SB(0, 0), b2, voffB); PG8_STAGE(PG8_SB(0, 1), b2 + hstep, voffB); PG8_STAGE(PG8_SA(0, 0), a2, voffA);
            PG8_WAIT_V(8); PG8_WAIT_L(0); PG8_BAR; PG8_MMA(1, 0, At, B0); PG8_MMA(1, 1, At, B1); PG8_BAR; PG8_SCHED;
            PG8_LDB(B0, 1, 0); PG8_LDB(B1, 1, 1); PG8_SCHED; PG8_LDA(At, 1, 0); PG8_STAGE(PG8_SA(0, 1), a2 + hstep, voffA);
            PG8_WAIT_V(8); PG8_WAIT_L(0); PG8_BAR; PG8_MMA(0, 0, At, B0); PG8_MMA(0, 1, At, B1); PG8_BAR; PG8_SCHED;
            PG8_LDA(At, 1, 1); PG8_STAGE(PG8_SB(1, 0), b3, voffB); PG8_STAGE(PG8_SB(1, 1), b3 + hstep, voffB); PG8_STAGE(PG8_SA(1, 0), a3, voffA);
            PG8_WAIT_V(8); PG8_WAIT_L(0); PG8_BAR; PG8_MMA(1, 0, At, B0); PG8_MMA(1, 1, At, B1); PG8_BAR; PG8_SCHED;
            } else {
            PG8_LDB(B0, 0, 0); PG8_SCHED; PG8_LDA(At, 0, 0); PG8_STAGE(PG8_SA(1, 1), a1 + hstep, voffA);
            PG8_WAIT_L(8); PG8_BAR; PG8_WAIT_L(0); PG8_MMA(0, 0, At, B0); PG8_BAR; PG8_SCHED;
            PG8_LDB(B1, 0, 1); PG8_STAGE(PG8_SB(0, 0), b2, voffB);
            PG8_BAR; PG8_WAIT_L(0); PG8_MMA(0, 1, At, B1); PG8_BAR;
            PG8_LDA(At, 0, 1); PG8_STAGE(PG8_SA(0, 0), a2, voffA);
            PG8_BAR; PG8_WAIT_L(0); PG8_MMA(1, 0, At, B0); PG8_BAR; PG8_SCHED;
            PG8_STAGE(PG8_SB(0, 1), b2 + hstep, voffB);
            PG8_WAIT_V(6); PG8_BAR; PG8_MMA(1, 1, At, B1); PG8_BAR;
            PG8_LDB(B0, 1, 0); PG8_SCHED; PG8_LDA(At, 1, 0); PG8_STAGE(PG8_SA(0, 1), a2 + hstep, voffA);
            PG8_WAIT_L(8); PG8_BAR; PG8_WAIT_L(0); PG8_MMA(0, 0, At, B0); PG8_BAR; PG8_SCHED;
            PG8_LDB(B1, 1, 1); PG8_STAGE(PG8_SB(1, 0), b3, voffB);
            PG8_BAR; PG8_WAIT_L(0); PG8_MMA(0, 1, At, B1); PG8_BAR;
            PG8_LDA(At, 1, 1); PG8_STAGE(PG8_SA(1, 0), a3, voffA);
            PG8_BAR; PG8_WAIT_L(0); PG8_MMA(1, 0, At, B0); PG8_BAR; PG8_SCHED;
            PG8_STAGE(PG8_SB(1, 1), b3 + hstep, voffB);
            PG8_WAIT_V(6); PG8_BAR; PG8_MMA(1, 1, At, B1); PG8_BAR;
            }
        }
        if constexpr (ALIGN_EPI) { if (wr == 0) PG8_BAR; }
        if constexpr (!Epi::AFTER_DRAIN) { E(acc, cur, wr, wc, fr, fq, pre); S.done(cur); }
        if (!has_next) break;
#pragma unroll
        for (int a = 0; a < 2; ++a)
#pragma unroll
            for (int b = 0; b < 2; ++b)
#pragma unroll
                for (int m = 0; m < 4; ++m)
#pragma unroll
                    for (int n = 0; n < 2; ++n) acc[a][b][m][n] = (f32x4){0.f, 0.f, 0.f, 0.f};
        cur = nxt; cA = nA; cB = nB; ++ui;
        pre = E.prefetch(cur, wr, fr);
        if constexpr (ALIGN_EPI) { if (wr == 1) PG8_BAR; }
    }
    PG8_WAIT_V(0);
    if constexpr (!ALIGN_EPI) { if (wr == 0) PG8_BAR; }
    PG8_BAR;
    if constexpr (Epi::AFTER_DRAIN) { E.fused(acc, cur, wr, wc, fr, fq, lds, wid, lane); S.done(cur); }
#undef PG8_SA
#undef PG8_SB
#undef PG8_STAGE
#undef PG8_LDA
#undef PG8_LDB
#undef PG8_MMA
#undef PG8_WAIT_V
#undef PG8_WAIT_L
#undef PG8_BAR
#undef PG8_SCHED
}
}
#define LAS __attribute__((address_space(3)))
typedef unsigned short bf16;
typedef unsigned v4u __attribute__((ext_vector_type(4)));
typedef unsigned v2u __attribute__((ext_vector_type(2)));
typedef float f32x4 __attribute__((ext_vector_type(4)));
typedef short bf16x8 __attribute__((ext_vector_type(8)));
typedef short s16x4 __attribute__((ext_vector_type(4)));
typedef short v4i16_t __attribute__((ext_vector_type(4)));
typedef float f32x16 __attribute__((ext_vector_type(16)));

constexpr int NB = 8, T = 2048, M = NB * T, D = 2048, FF = 5632, NGU = 2 * FF, NPJ = 7168, NPJ_PAD = 7424, NIN = 7184, NCH = 16;
constexpr int PQ_MQ = 0, PQ_MK = 512, PQ_MV = 1024, PQ_MO = 1536, PQ_NQ = 2048, PQ_NK = 3072, PQ_NV = 4096, PQ_RQ = 5120, PQ_RK = 5632, PQ_RV = 6144, PQ_RG = 6656;
constexpr float EPS = 1e-6f, NEGF = -1e30f, LOG2E = 1.4426950408889634f, QSCALE = 0.08838834764831845f;
constexpr size_t MiB = 1u << 20;
constexpr size_t WS_WGU = 1 * MiB;
constexpr size_t SZ_WGU = (size_t)NGU * D * 2;
constexpr size_t WS_WDN = WS_WGU + 2 * SZ_WGU;
constexpr size_t SZ_WDN = (size_t)D * FF * 2;
constexpr size_t WS_WIN = WS_WDN + 2 * SZ_WDN;
constexpr size_t WS_WOUT = WS_WIN + (size_t)NPJ_PAD * D * 2;
constexpr size_t WS_XN = WS_WOUT + (size_t)D * D * 2;
constexpr size_t WS_PROJ = WS_XN + (size_t)M * D * 2;
constexpr size_t WS_GATES = WS_PROJ + (size_t)M * NPJ * 2;
constexpr size_t WS_CLOC = WS_GATES + (size_t)M * 16 * 4;
constexpr size_t WS_CST = WS_CLOC + (size_t)2048 * 16384 * 4;
constexpr size_t WS_NLOC = WS_CST + (size_t)2048 * 16384 * 2;
constexpr size_t WS_NST = WS_NLOC + (size_t)1024 * 128 * 4;
constexpr size_t WS_MLOC = WS_NST + (size_t)1024 * 128 * 4;
constexpr size_t WS_GTOT = WS_MLOC + 4096;
constexpr size_t WS_MST = WS_GTOT + 4096;
constexpr size_t WS_ROWSQ = WS_MST + 4096;
constexpr size_t WS_MQK = WS_ROWSQ + (size_t)9 * M * 4;
constexpr size_t WS_END = WS_MQK + (size_t)M * 1024 * 2;
static_assert(WS_END < (size_t)690 * MiB, "workspace map");

struct Params { const float* in[18]; float* out; unsigned char* ws; };
enum { I_X = 0, I_F1N, I_F1GU, I_F1DN, I_MIXN, I_WIN, I_CONVW, I_CONVB, I_GATEB, I_MHN, I_RPB, I_DECAY, I_RHN, I_WOUT, I_F2N, I_F2GU, I_F2DN, I_FINN };

constexpr int LDS_BYTES = 148480, MISC_OFF = 147712, GRID = 256;
constexpr int IMG_STRIDE = 288;
constexpr int IMG_BYTES = 128 * IMG_STRIDE;
constexpr int CT_STRIDE = 272, CT_BYTES = 128 * CT_STRIDE;
constexpr int LDS_IMG0 = 0, LDS_IMG1 = IMG_BYTES, LDS_IMG2 = 2 * IMG_BYTES, LDS_CT0 = 2 * IMG_BYTES, LDS_SCAL = 2 * IMG_BYTES + 2 * CT_BYTES;
static_assert(3 * IMG_BYTES <= LDS_SCAL && LDS_SCAL + 1056 * 4 <= MISC_OFF && MISC_OFF + 128 <= LDS_BYTES, "LDS map");

__device__ __forceinline__ float bf2f(unsigned short b) { return __uint_as_float((unsigned)b << 16); }
__device__ __forceinline__ unsigned pk2(float lo, float hi) { return pg8::cvt_pk_bf16(lo, hi); }
__device__ __forceinline__ float lo2f(unsigned w) { return __uint_as_float(w << 16); }
__device__ __forceinline__ float hi2f(unsigned w) { return __uint_as_float(w & 0xffff0000u); }
__device__ __forceinline__ float wave_sum(float v) {
#pragma unroll
    for (int o = 1; o < 64; o <<= 1) v += __shfl_xor(v, o);
    return v;
}
__device__ __forceinline__ float wave_max(float v) {
#pragma unroll
    for (int o = 1; o < 64; o <<= 1) v = fmaxf(v, __shfl_xor(v, o));
    return v;
}
__device__ __forceinline__ float silu_f(float x) { return pg8::silu_f(x); }
__device__ __forceinline__ float sigmoid_f(float x) { return __builtin_amdgcn_rcpf(1.0f + __builtin_amdgcn_exp2f(-LOG2E * x)); }
__device__ __forceinline__ float logsig_f(float x) { return fminf(x, 0.f) - log1pf(expf(-fabsf(x))); }
__device__ __forceinline__ float exp_f(float x) { return __builtin_amdgcn_exp2f(x * LOG2E); }
__device__ __forceinline__ s16x4 tr_read(const LAS unsigned char* p) { return __builtin_bit_cast(s16x4, __builtin_amdgcn_ds_read_tr16_b64_v4i16((LAS v4i16_t*)p)); }
#define LDS_WAIT() asm volatile("s_waitcnt lgkmcnt(0)" ::: "memory")

template <int MAP> __device__ __forceinline__ int map_row(int n) {
    if (MAP == 1) { const int bj = n >= FF ? 1 : 0, j = n - bj * FF; return (j >> 7) * 256 + bj * 128 + (j & 127); }
    if (MAP == 2) { return n < 2048 ? n : (n < 2064 ? NPJ + (n - 2048) : n - 16); }
    return n;
}
template <int MAP> __device__ __forceinline__ void transpose_item(const float* __restrict__ W, int K, int N, bf16* __restrict__ WT, LAS float* scr, int item, int lane, const float* __restrict__ gain) {
    const int nblk = (N + 31) / 32, kb = item / nblk, nb = item - kb * nblk, k0 = 64 * kb, n0 = 32 * nb;
    const int nq = 4 * (lane & 7), kr = lane >> 3; const bool ok = n0 + nq < N;
    const float* src = W + (size_t)(k0 + kr) * N + (ok ? n0 + nq : 0);
#pragma unroll
    for (int i = 0; i < 8; ++i) { f32x4 v = *(const f32x4*)(src + (size_t)(8 * i) * N); if (!ok) v = (f32x4){0.f, 0.f, 0.f, 0.f};
        LAS float* d = scr + (8 * i + kr) * 33 + nq; d[0] = v.x; d[1] = v.y; d[2] = v.z; d[3] = v.w; }
    LDS_WAIT(); asm volatile("" ::: "memory");
    const int c = lane & 7;
    f32x4 g0 = {1.f, 1.f, 1.f, 1.f}, g1 = {1.f, 1.f, 1.f, 1.f};
    if (gain) { g0 = *(const f32x4*)(gain + k0 + 8 * c); g1 = *(const f32x4*)(gain + k0 + 8 * c + 4); }
#pragma unroll
    for (int j = 0; j < 4; ++j) { const int n = (lane >> 3) + 8 * j; const LAS float* s = scr + (8 * c) * 33 + n;
        v4u o; o.x = pk2(s[0 * 33] * g0.x, s[1 * 33] * g0.y); o.y = pk2(s[2 * 33] * g0.z, s[3 * 33] * g0.w); o.z = pk2(s[4 * 33] * g1.x, s[5 * 33] * g1.y); o.w = pk2(s[6 * 33] * g1.z, s[7 * 33] * g1.w);
        if (n0 + n < N) *(v4u*)(WT + (size_t)map_row<MAP>(n0 + n) * K + k0 + 8 * c) = o; }
    LDS_WAIT(); asm volatile("" ::: "memory");
}
__device__ __forceinline__ void convert_weights(const Params& P, int l, LAS unsigned char* lds, int wv) {
    const int tid = tid_fresh(wv), lane = tid & 63, wave = tid >> 6;
    LAS float* scr = (LAS float*)(lds + wave * 8448);
    const int gw = blockIdx.x * 8 + wave, NGW = GRID * 8;
    bf16* wgu = (bf16*)(P.ws + WS_WGU); bf16* wdn = (bf16*)(P.ws + WS_WDN); bf16* win = (bf16*)(P.ws + WS_WIN); bf16* wout = (bf16*)(P.ws + WS_WOUT);
    constexpr int I_GU = (D / 64) * (NGU / 32), I_DN = (FF / 64) * (D / 32), I_IN = (D / 64) * ((NIN + 31) / 32), I_OUT = (D / 64) * (D / 32);
    constexpr int NITEMS = 2 * I_GU + 2 * I_DN + I_IN + I_OUT;
#pragma unroll 1
    for (int it = gw; it < NITEMS; it += NGW) {
        int r = it;
        if (r < I_GU) { transpose_item<1>(P.in[I_F1GU] + (size_t)l * D * NGU, D, NGU, wgu, scr, r, lane, P.in[I_F1N] + (size_t)l * D); continue; } r -= I_GU;
        if (r < I_GU) { transpose_item<1>(P.in[I_F2GU] + (size_t)l * D * NGU, D, NGU, wgu + (size_t)NGU * D, scr, r, lane, P.in[I_F2N] + (size_t)l * D); continue; } r -= I_GU;
        if (r < I_DN) { transpose_item<0>(P.in[I_F1DN] + (size_t)l * FF * D, FF, D, wdn, scr, r, lane, nullptr); continue; } r -= I_DN;
        if (r < I_DN) { transpose_item<0>(P.in[I_F2DN] + (size_t)l * FF * D, FF, D, wdn + (size_t)D * FF, scr, r, lane, nullptr); continue; } r -= I_DN;
        if (r < I_IN) { transpose_item<2>(P.in[I_WIN] + (size_t)l * D * NIN, D, NIN, win, scr, r, lane, P.in[I_MIXN] + (size_t)l * D); continue; } r -= I_IN;
        transpose_item<0>(P.in[I_WOUT] + (size_t)l * D * D, D, D, wout, scr, r, lane, nullptr);
    }
}
__device__ __forceinline__ void cast_rows_bf16(const float* src, bf16* dst, unsigned* rowsq, int wv) {
    const int tid = tid_fresh(wv), lane = tid & 63, wave = tid >> 6, gw = blockIdx.x * 8 + wave, NGW = GRID * 8;
#pragma unroll 1
    for (int m = gw; m < M; m += NGW) {
        const f32x4* xr = (const f32x4*)(src + (size_t)m * D) + lane;
        f32x4 v[8]; float s = 0.f;
#pragma unroll
        for (int j = 0; j < 8; ++j) { v[j] = xr[64 * j]; s += (v[j].x * v[j].x + v[j].y * v[j].y) + (v[j].z * v[j].z + v[j].w * v[j].w); }
        s = wave_sum(s);
        v2u* o = (v2u*)(dst + (size_t)m * D) + lane;
#pragma unroll
        for (int j = 0; j < 8; ++j) o[64 * j] = (v2u){pk2(v[j].x, v[j].y), pk2(v[j].z, v[j].w)};
        if (lane == 0) rowsq[m] = (unsigned)(s * 4096.0f + 0.5f);
    }
}
__device__ __forceinline__ void rms_rows_f32(const float* src, const float* __restrict__ gain, float* dst, int wv) {
    const int tid = tid_fresh(wv), lane = tid & 63, wave = tid >> 6, gw = blockIdx.x * 8 + wave, NGW = GRID * 8;
    f32x4 gv[8];
#pragma unroll
    for (int j = 0; j < 8; ++j) gv[j] = *(const f32x4*)(gain + 4 * lane + 256 * j);
#pragma unroll 1
    for (int m = gw; m < M; m += NGW) {
        const f32x4* xr = (const f32x4*)(src + (size_t)m * D) + lane;
        f32x4 v[8]; float s = 0.f;
#pragma unroll
        for (int j = 0; j < 8; ++j) { v[j] = xr[64 * j]; s += (v[j].x * v[j].x + v[j].y * v[j].y) + (v[j].z * v[j].z + v[j].w * v[j].w); }
        const float rstd = rsqrtf(wave_sum(s) * (1.f / D) + EPS);
        f32x4* o = (f32x4*)(dst + (size_t)m * D) + lane;
#pragma unroll
        for (int j = 0; j < 8; ++j) o[64 * j] = v[j] * rstd * gv[j];
    }
}
__device__ __forceinline__ size_t st_idx(int typ, int b, int h, int dir, int oc) { return ((((size_t)typ * 8 + b) * 4 + h) * 2 + dir) * 16 + oc; }
__device__ __forceinline__ bf16x8 tr_frag32(const LAS unsigned char* img, int s0, int c0, int lane) {
    const int hh = lane >> 5, grp = (lane >> 4) & 1, q = (lane & 15) >> 2, p = lane & 3;
    const LAS unsigned char* a = img + (s0 + 8 * hh + q) * IMG_STRIDE + (c0 + 16 * grp + 4 * p) * 2;
    const s16x4 lo = tr_read(a), hi = tr_read(a + 4 * IMG_STRIDE);
    return (bf16x8){lo[0], lo[1], lo[2], lo[3], hi[0], hi[1], hi[2], hi[3]};
}
__device__ __forceinline__ bf16x8 tr_frag16p(const LAS unsigned char* img, int stride, int s0, int c0, int lane) {
    const int g = lane >> 4, q = (lane & 15) >> 2, p = lane & 3;
    const LAS unsigned char* a = img + (s0 + 4 * g + q) * stride + (c0 + 4 * p) * 2;
    const s16x4 lo = tr_read(a), hi = tr_read(a + 16 * stride);
    return (bf16x8){lo[0], lo[1], lo[2], lo[3], hi[0], hi[1], hi[2], hi[3]};
}
template <bool REV, bool MAXOP> __device__ __forceinline__ void wave_scan128(const LAS float* in, LAS float* out, int lane) {
    const int i0 = REV ? 127 - 2 * lane : 2 * lane, i1 = REV ? 126 - 2 * lane : 2 * lane + 1;
    const float x0 = in[i0], x1 = in[i1];
    const float pr = MAXOP ? fmaxf(x0, x1) : x0 + x1;
    float s = pr;
#pragma unroll
    for (int o = 1; o < 64; o <<= 1) { const float y = __shfl_up(s, o); if (lane >= o) s = MAXOP ? fmaxf(s, y) : s + y; }
    float ex = __shfl_up(s, 1);
    if (MAXOP) { ex = lane ? ex : NEGF; out[i0] = fmaxf(ex, x0); out[i1] = fmaxf(ex, pr); }
    else { ex = lane ? ex : 0.f; out[i0] = ex + x0; out[i1] = ex + pr; }
}
__device__ __forceinline__ void rope_cs(int pos, int idx, float& c, float& s) {
    const float inv = exp2f(-(float)idx * 0.20762050593046014f);
    float r = (float)pos * inv; r *= 0.15915494309189535f; r -= floorf(r);
    c = __builtin_amdgcn_cosf(r); s = __builtin_amdgcn_sinf(r);
}
enum { S_LIF = 0, S_BF = 128, S_LIB = 256, S_BB = 384, S_T0 = 512, S_T1 = 640, S_PMF = 768, S_PMB = 896, S_RED = 1024 };
__device__ __forceinline__ void mlstm_scalars(const Params& P, int l, int b, int h, int oc, LAS float* sc, int wv) {
    const int tid = tid_fresh(wv), lane = tid & 63, wave = tid >> 6;
    if (tid < 128) {
        const float* g = (const float*)(P.ws + WS_GATES) + (size_t)(b * T + oc * 128 + tid) * 16; const float* gb = P.in[I_GATEB] + l * 16;
        sc[S_LIF + tid] = g[h] + gb[h]; sc[S_T0 + tid] = logsig_f(g[4 + h] + gb[4 + h]);
        sc[S_LIB + tid] = g[8 + h] + gb[8 + h]; sc[S_T1 + tid] = logsig_f(g[12 + h] + gb[12 + h]);
    }
    __syncthreads();
    if (wave == 0) wave_scan128<false, false>(sc + S_T0, sc + S_BF, lane);
    if (wave == 1) wave_scan128<true, false>(sc + S_T1, sc + S_BB, lane);
    __syncthreads();
}
template <bool MAXOP> __device__ __forceinline__ void scan2(float x0, float x1, int lane, float& y0, float& y1) {
    const float pr = MAXOP ? fmaxf(x0, x1) : x0 + x1;
    float s = pr;
#pragma unroll
    for (int o = 1; o < 64; o <<= 1) { const float y = __shfl_up(s, o); if (lane >= o) s = MAXOP ? fmaxf(s, y) : s + y; }
    float ex = __shfl_up(s, 1);
    if (MAXOP) { ex = lane ? ex : NEGF; y0 = fmaxf(ex, x0); y1 = fmaxf(ex, pr); }
    else { ex = lane ? ex : 0.f; y0 = ex + x0; y1 = ex + pr; }
}
template <bool REV, int MODE> __device__ __forceinline__ void wave_gate_scalars(const Params& P, int l, int b, int h, int oc, LAS float* sc, int lane, int wofs, int bofs, int pofs, size_t sidx) {
    const int i0 = REV ? 127 - 2 * lane : 2 * lane, i1 = REV ? 126 - 2 * lane : 2 * lane + 1;
    const float* g = (const float*)(P.ws + WS_GATES) + (size_t)(b * T + oc * 128) * 16; const float* gb = P.in[I_GATEB] + l * 16;
    const int ci = (REV ? 8 : 0) + h, cf = (REV ? 12 : 4) + h;
    const float li0 = g[i0 * 16 + ci] + gb[ci], li1 = g[i1 * 16 + ci] + gb[ci];
    const float lf0 = logsig_f(g[i0 * 16 + cf] + gb[cf]), lf1 = logsig_f(g[i1 * 16 + cf] + gb[cf]);
    float b0, b1; scan2<false>(lf0, lf1, lane, b0, b1);
    if (MODE == 0) {
        const float gtot = __shfl(b1, 63);
        const float a0 = gtot - b0 + li0, a1 = gtot - b1 + li1;
        const float mloc = wave_max(fmaxf(a0, a1));
        sc[wofs + i0] = exp_f(a0 - mloc); sc[wofs + i1] = exp_f(a1 - mloc);
        if (lane == 0) { ((float*)(P.ws + WS_MLOC))[sidx] = mloc; ((float*)(P.ws + WS_GTOT))[sidx] = gtot; }
    } else {
        const float u0 = li0 - b0, u1 = li1 - b1;
        float p0, p1; scan2<true>(u0, u1, lane, p0, p1);
        const float cmax = wave_max(fmaxf(u0, u1));
        sc[bofs + i0] = b0; sc[bofs + i1] = b1; sc[wofs + i0] = exp_f(fmaxf(u0 - cmax, -80.f)); sc[wofs + i1] = exp_f(fmaxf(u1 - cmax, -80.f)); sc[pofs + i0] = p0; sc[pofs + i1] = p1;
        if (lane == 0) sc[S_RED + (REV ? 1 : 0)] = cmax;
    }
}
__device__ __forceinline__ void prep_phase(const Params& P, int l, int wv) {
    const int tid = tid_fresh(wv), lane = tid & 63, wave = tid >> 6, gw = blockIdx.x * 8 + wave, NGW = GRID * 8;
    bf16* proj = (bf16*)(P.ws + WS_PROJ); bf16* mqk = (bf16*)(P.ws + WS_MQK);
    const float* cw = P.in[I_CONVW] + (size_t)l * 3 * 1024; const float* cb = P.in[I_CONVB] + (size_t)l * 1024;
#pragma unroll 1
    for (int m = gw; m < M; m += NGW) {
        const int t = m & (T - 1);
#pragma unroll
        for (int half = 0; half < 2; ++half) {
            const int c0 = half * 512 + 8 * lane;
            const f32x4 b0 = *(const f32x4*)(cb + c0), b1 = *(const f32x4*)(cb + c0 + 4);
            float y[8] = {b0.x, b0.y, b0.z, b0.w, b1.x, b1.y, b1.z, b1.w};
#pragma unroll
            for (int j = 0; j < 3; ++j) { const int tt = t + j - 1; const float ok = (tt >= 0 && tt < T) ? 1.f : 0.f; const int mc = m + (tt < 0 ? 0 : (tt >= T ? 0 : j - 1));
                const v4u a = *(const v4u*)(proj + (size_t)mc * NPJ + PQ_MQ + c0);
                const f32x4 w0 = *(const f32x4*)(cw + j * 1024 + c0) * ok, w1 = *(const f32x4*)(cw + j * 1024 + c0 + 4) * ok;
                y[0] += w0.x * lo2f(a.x); y[1] += w0.y * hi2f(a.x); y[2] += w0.z * lo2f(a.y); y[3] += w0.w * hi2f(a.y);
                y[4] += w1.x * lo2f(a.z); y[5] += w1.y * hi2f(a.z); y[6] += w1.z * lo2f(a.w); y[7] += w1.w * hi2f(a.w); }
            const float sc = half ? 1.0f : QSCALE;
            *(v4u*)(mqk + (size_t)m * 1024 + c0) = (v4u){pk2(silu_f(y[0]) * sc, silu_f(y[1]) * sc), pk2(silu_f(y[2]) * sc, silu_f(y[3]) * sc), pk2(silu_f(y[4]) * sc, silu_f(y[5]) * sc), pk2(silu_f(y[6]) * sc, silu_f(y[7]) * sc)};
        }
        { const int isk = lane >> 5, hd = (lane >> 3) & 3, ch = lane & 7;
          bf16* rp = proj + (size_t)m * NPJ + (isk ? PQ_RK : PQ_RQ) + hd * 128 + 8 * ch;
          const v4u a = *(const v4u*)rp, pb = *(const v4u*)(rp + 64);
          const float x1[8] = {lo2f(a.x), hi2f(a.x), lo2f(a.y), hi2f(a.y), lo2f(a.z), hi2f(a.z), lo2f(a.w), hi2f(a.w)};
          const float x2[8] = {lo2f(pb.x), hi2f(pb.x), lo2f(pb.y), hi2f(pb.y), lo2f(pb.z), hi2f(pb.z), lo2f(pb.w), hi2f(pb.w)};
          const float sc = isk ? QSCALE : 1.0f; float o1[8], o2[8];
#pragma unroll
          for (int i = 0; i < 8; ++i) { float c, s; rope_cs(t, 8 * ch + i, c, s); o1[i] = (x1[i] * c - x2[i] * s) * sc; o2[i] = (x1[i] * s + x2[i] * c) * sc; }
          *(v4u*)rp = (v4u){pk2(o1[0], o1[1]), pk2(o1[2], o1[3]), pk2(o1[4], o1[5]), pk2(o1[6], o1[7])};
          *(v4u*)(rp + 64) = (v4u){pk2(o2[0], o2[1]), pk2(o2[2], o2[3]), pk2(o2[4], o2[5]), pk2(o2[6], o2[7])}; }
    }
}
template <bool RET> __device__ __forceinline__ v4u k_packed(const Params& P, int b, int t, int h, int ch) {
    if (RET) return *(const v4u*)((const bf16*)(P.ws + WS_PROJ) + (size_t)(b * T + t) * NPJ + PQ_RK + h * 128 + 8 * ch);
    return *(const v4u*)((const bf16*)(P.ws + WS_MQK) + (size_t)(b * T + t) * 1024 + 512 + h * 128 + 8 * ch);
}
template <bool RET> __device__ __forceinline__ void q_frags(const Params& P, int b, int t, int h, int g, bf16x8 (&qf)[4]) {
    const bf16* qp = RET ? (const bf16*)(P.ws + WS_PROJ) + (size_t)(b * T + t) * NPJ + PQ_RQ + h * 128 + 8 * g : (const bf16*)(P.ws + WS_MQK) + (size_t)(b * T + t) * 1024 + h * 128 + 8 * g;
#pragma unroll
    for (int ks = 0; ks < 4; ++ks) qf[ks] = *(const bf16x8*)(qp + 32 * ks);
}
__device__ __forceinline__ float ret_log2g(const Params& P, int l, int dir, int h) { return logsig_f(P.in[I_DECAY][l * 8 + dir * 4 + h]) * LOG2E; }

template <bool RET> __device__ __forceinline__ void lin_local_unit(const Params& P, int l, int b, int h, int oc, LAS unsigned char* lds, int wv) {
    const int tid = tid_fresh(wv), lane = tid & 63, wave = tid >> 6;
    LAS float* sc = (LAS float*)(lds + LDS_SCAL);
    const bf16* proj = (const bf16*)(P.ws + WS_PROJ);
    const size_t i0 = st_idx(RET ? 1 : 0, b, h, 0, oc), i1 = st_idx(RET ? 1 : 0, b, h, 1, oc);
    v4u vv[4], kp[4];
#pragma unroll
    for (int it = 0; it < 4; ++it) {
        const int id = it * 512 + tid, s = id >> 4, ch = id & 15;
        vv[it] = *(const v4u*)(proj + (size_t)(b * T + oc * 128 + s) * NPJ + (RET ? PQ_RV : PQ_MV) + h * 128 + 8 * ch);
        kp[it] = k_packed<RET>(P, b, oc * 128 + s, h, ch);
    }
    float lgF = 0.f, lgB = 0.f;
    if (RET) { lgF = ret_log2g(P, l, 0, h); lgB = ret_log2g(P, l, 1, h); }
    else {
        if (wave == 0) wave_gate_scalars<false, 0>(P, l, b, h, oc, sc, lane, S_T0, 0, 0, i0);
        if (wave == 1) wave_gate_scalars<true, 0>(P, l, b, h, oc, sc, lane, S_T1, 0, 0, i1);
        __syncthreads();
    }
#pragma unroll
    for (int it = 0; it < 4; ++it) {
        const int id = it * 512 + tid, s = id >> 4, ch = id & 15;
        *(LAS v4u*)(lds + LDS_IMG0 + s * IMG_STRIDE + ch * 16) = vv[it];
        const float wF = RET ? __builtin_amdgcn_exp2f((float)(127 - s) * lgF) : sc[S_T0 + s], wB = RET ? __builtin_amdgcn_exp2f((float)s * lgB) : sc[S_T1 + s];
        const float k[8] = {lo2f(kp[it].x), hi2f(kp[it].x), lo2f(kp[it].y), hi2f(kp[it].y), lo2f(kp[it].z), hi2f(kp[it].z), lo2f(kp[it].w), hi2f(kp[it].w)};
        *(LAS v4u*)(lds + LDS_IMG1 + s * IMG_STRIDE + ch * 16) = (v4u){pk2(k[0] * wF, k[1] * wF), pk2(k[2] * wF, k[3] * wF), pk2(k[4] * wF, k[5] * wF), pk2(k[6] * wF, k[7] * wF)};
        *(LAS v4u*)(lds + LDS_IMG2 + s * IMG_STRIDE + ch * 16) = (v4u){pk2(k[0] * wB, k[1] * wB), pk2(k[2] * wB, k[3] * wB), pk2(k[4] * wB, k[5] * wB), pk2(k[6] * wB, k[7] * wB)};
    }
    __syncthreads();
    const int et = wave & 3, dp = wave >> 2;
    f32x16 acc[2][2];
#pragma unroll
    for (int a = 0; a < 2; ++a)
#pragma unroll
        for (int c = 0; c < 2; ++c)
#pragma unroll
            for (int r = 0; r < 16; ++r) acc[a][c][r] = 0.f;
#pragma unroll 2
    for (int ks = 0; ks < 8; ++ks) {
        const bf16x8 av = tr_frag32(lds + LDS_IMG0, 16 * ks, 32 * et, lane);
#pragma unroll
        for (int dir = 0; dir < 2; ++dir)
#pragma unroll
            for (int c = 0; c < 2; ++c) { const bf16x8 bk = tr_frag32(lds + (dir ? LDS_IMG2 : LDS_IMG1), 16 * ks, 32 * (2 * dp + c), lane);
                acc[dir][c] = __builtin_amdgcn_mfma_f32_32x32x16_bf16(av, bk, acc[dir][c], 0, 0, 0); }
    }
    bf16* ct = (bf16*)(P.ws + WS_CLOC);
#pragma unroll
    for (int dir = 0; dir < 2; ++dir)
#pragma unroll
        for (int c = 0; c < 2; ++c)
#pragma unroll
            for (int r = 0; r < 16; ++r) { const int e = 32 * et + (r & 3) + 8 * (r >> 2) + 4 * (lane >> 5), d = 32 * (2 * dp + c) + (lane & 31);
                ct[(dir ? i1 : i0) * 16384 + (size_t)e * 128 + d] = (bf16)(pk2(acc[dir][c][r], 0.f) & 0xffffu); }
    if (!RET && tid < 256) {
        const int dir = tid >> 7, d = tid & 127; const LAS unsigned short* img = (const LAS unsigned short*)(lds + (dir ? LDS_IMG2 : LDS_IMG1)) + d;
        float s = 0.f;
#pragma unroll 8
        for (int r = 0; r < 128; ++r) s += bf2f(img[r * (IMG_STRIDE / 2)]);
        ((float*)(P.ws + WS_NLOC))[(dir ? i1 : i0) * 128 + d] = s;
    }
    __syncthreads();
}
template <bool RET> __device__ __forceinline__ void lin_out_unit(const Params& P, int l, int b, int h, int oc, LAS unsigned char* lds, int wv) {
    const int tid = tid_fresh(wv), lane = tid & 63, wave = tid >> 6, g = lane >> 4, li = lane & 15;
    LAS float* sc = (LAS float*)(lds + LDS_SCAL);
    const bf16* proj = (const bf16*)(P.ws + WS_PROJ);
    const size_t i0 = st_idx(RET ? 1 : 0, b, h, 0, oc), i1 = st_idx(RET ? 1 : 0, b, h, 1, oc);
    const int tq = 16 * wave + li;
    bf16x8 qf[4]; q_frags<RET>(P, b, oc * 128 + tq, h, g, qf);
    v2u gwv[8];
    { const bf16* gp0 = proj + (size_t)(b * T + oc * 128 + tq) * NPJ + (RET ? PQ_RG : PQ_MO) + h * 128 + 4 * g;
#pragma unroll
      for (int et = 0; et < 8; ++et) gwv[et] = *(const v2u*)(gp0 + 16 * et); }
    v4u vv[4], kp[4], c0v[4], c1v[4];
    { const bf16* ct0 = (const bf16*)(P.ws + WS_CST) + i0 * 16384; const bf16* ct1 = (const bf16*)(P.ws + WS_CST) + i1 * 16384;
#pragma unroll
      for (int it = 0; it < 4; ++it) { const int id = it * 512 + tid, s = id >> 4, ch = id & 15;
        vv[it] = *(const v4u*)(proj + (size_t)(b * T + oc * 128 + s) * NPJ + (RET ? PQ_RV : PQ_MV) + h * 128 + 8 * ch);
        kp[it] = k_packed<RET>(P, b, oc * 128 + s, h, ch);
        c0v[it] = *(const v4u*)(ct0 + (size_t)s * 128 + 8 * ch); c1v[it] = *(const v4u*)(ct1 + (size_t)s * 128 + 8 * ch); } }
#pragma unroll
    for (int it = 0; it < 4; ++it) { const int id = it * 512 + tid, s = id >> 4, ch = id & 15;
        *(LAS v4u*)(lds + LDS_IMG0 + s * IMG_STRIDE + ch * 16) = vv[it]; *(LAS v4u*)(lds + LDS_IMG1 + s * IMG_STRIDE + ch * 16) = kp[it];
        *(LAS v4u*)(lds + LDS_CT0 + s * CT_STRIDE + ch * 16) = c0v[it]; *(LAS v4u*)(lds + LDS_CT0 + CT_BYTES + s * CT_STRIDE + ch * 16) = c1v[it]; }
    float lgF = 0.f, lgB = 0.f;
    if (!RET) {
        if (wave == 0) wave_gate_scalars<false, 1>(P, l, b, h, oc, sc, lane, S_T0, S_BF, S_PMF, 0);
        if (wave == 1) wave_gate_scalars<true, 1>(P, l, b, h, oc, sc, lane, S_T1, S_BB, S_PMB, 0);
    } else {
        lgF = ret_log2g(P, l, 0, h); lgB = ret_log2g(P, l, 1, h);
        if (tid < 128) { sc[S_T0 + tid] = __builtin_amdgcn_exp2f(-(float)tid * lgF); sc[S_T1 + tid] = __builtin_amdgcn_exp2f((float)tid * lgB); }
    }
    __syncthreads();
    f32x4 sT[8];
#pragma unroll
    for (int kt = 0; kt < 8; ++kt) { f32x4 a = {0.f, 0.f, 0.f, 0.f};
#pragma unroll
        for (int ks = 0; ks < 4; ++ks) { const bf16x8 kf = *(const LAS bf16x8*)(lds + LDS_IMG1 + (16 * kt + li) * IMG_STRIDE + (32 * ks + 8 * g) * 2);
            a = __builtin_amdgcn_mfma_f32_16x16x32_bf16(kf, qf[ks], a, 0, 0, 0); }
        sT[kt] = a; }
    float alF, alB, cF, cB;
    float dmF[4], dmB[4];
#pragma unroll
    for (int j = 0; j < 4; ++j) { const int d = 4 * g + j - li; dmF[j] = d <= 0 ? 1.f : 0.f; dmB[j] = d >= 0 ? 1.f : 0.f; }
    if (RET) {
        cF = __builtin_amdgcn_exp2f((float)tq * lgF); cB = __builtin_amdgcn_exp2f(-(float)tq * lgB);
        alF = __builtin_amdgcn_exp2f((float)(tq + 1) * lgF); alB = __builtin_amdgcn_exp2f((float)(128 - tq) * lgB);
    } else {
        const float mCF = ((const float*)(P.ws + WS_MST))[i0], mCB = ((const float*)(P.ws + WS_MST))[i1];
        const float kapF = fmaxf(mCF, sc[S_PMF + tq]), kapB = fmaxf(mCB, sc[S_PMB + tq]);
        const float mF = kapF + sc[S_BF + tq], mB = kapB + sc[S_BB + tq];
        const float wiF = exp_f(mCF - kapF), wiB = exp_f(mCB - kapB);
        const float RF = exp_f(fminf(sc[S_RED + 0] - kapF, 80.f)), RB = exp_f(fminf(sc[S_RED + 1] - kapB, 80.f));
        float sumF = 0.f, sumB = 0.f;
#pragma unroll
        for (int kt = 0; kt < 8; ++kt) { const f32x4 eF = *(const LAS f32x4*)(sc + S_T0 + 16 * kt + 4 * g), eB = *(const LAS f32x4*)(sc + S_T1 + 16 * kt + 4 * g);
            const float tf = kt < wave ? 1.f : 0.f, te = kt == wave ? 1.f : 0.f, tb = kt > wave ? 1.f : 0.f;
#pragma unroll
            for (int j = 0; j < 4; ++j) { sumF += sT[kt][j] * (eF[j] * (tf + te * dmF[j])); sumB += sT[kt][j] * (eB[j] * (tb + te * dmB[j])); } }
        sumF += __shfl_xor(sumF, 16); sumF += __shfl_xor(sumF, 32); sumB += __shfl_xor(sumB, 16); sumB += __shfl_xor(sumB, 32);
        const float* nF = (const float*)(P.ws + WS_NST) + i0 * 128; const float* nB = (const float*)(P.ws + WS_NST) + i1 * 128;
        float qnF = 0.f, qnB = 0.f;
#pragma unroll
        for (int ks = 0; ks < 4; ++ks) { const f32x4 a0 = *(const f32x4*)(nF + 32 * ks + 8 * g), a1 = *(const f32x4*)(nF + 32 * ks + 8 * g + 4), c0 = *(const f32x4*)(nB + 32 * ks + 8 * g), c1 = *(const f32x4*)(nB + 32 * ks + 8 * g + 4);
            const v4u qw = __builtin_bit_cast(v4u, qf[ks]);
            const float q0 = lo2f(qw.x), q1 = hi2f(qw.x), q2 = lo2f(qw.y), q3 = hi2f(qw.y), q4 = lo2f(qw.z), q5 = hi2f(qw.z), q6 = lo2f(qw.w), q7 = hi2f(qw.w);
            qnF += q0 * a0.x + q1 * a0.y + q2 * a0.z + q3 * a0.w + q4 * a1.x + q5 * a1.y + q6 * a1.z + q7 * a1.w;
            qnB += q0 * c0.x + q1 * c0.y + q2 * c0.z + q3 * c0.w + q4 * c1.x + q5 * c1.y + q6 * c1.z + q7 * c1.w; }
        qnF += __shfl_xor(qnF, 16); qnF += __shfl_xor(qnF, 32); qnB += __shfl_xor(qnB, 16); qnB += __shfl_xor(qnB, 32);
        const float denF = RF * sumF + wiF * qnF, denB = RB * sumB + wiB * qnB;
        const float rF = 1.0f / fmaxf(fabsf(denF), exp_f(-mF)), rB = 1.0f / fmaxf(fabsf(denB), exp_f(-mB));
        cF = RF * rF; cB = RB * rB; alF = rF * wiF; alB = rB * wiB;
    }
#pragma unroll
    for (int kt = 0; kt < 8; ++kt) { const f32x4 eF = *(const LAS f32x4*)(sc + S_T0 + 16 * kt + 4 * g), eB = *(const LAS f32x4*)(sc + S_T1 + 16 * kt + 4 * g);
        const float tf = kt < wave ? cF : 0.f, teF = kt == wave ? cF : 0.f, tb = kt > wave ? cB : 0.f, teB = kt == wave ? cB : 0.f;
#pragma unroll
        for (int j = 0; j < 4; ++j) sT[kt][j] *= eF[j] * (tf + teF * dmF[j]) + eB[j] * (tb + teB * dmB[j]); }
    f32x4 O[8];
#pragma unroll
    for (int et = 0; et < 8; ++et) O[et] = (f32x4){0.f, 0.f, 0.f, 0.f};
#pragma unroll
    for (int ks = 0; ks < 4; ++ks) {
        const v4u pw = {pk2(sT[2 * ks][0], sT[2 * ks][1]), pk2(sT[2 * ks][2], sT[2 * ks][3]), pk2(sT[2 * ks + 1][0], sT[2 * ks + 1][1]), pk2(sT[2 * ks + 1][2], sT[2 * ks + 1][3])};
        const bf16x8 pf = __builtin_bit_cast(bf16x8, pw);
#pragma unroll
        for (int et = 0; et < 8; ++et) { const bf16x8 vf = tr_frag16p(lds + LDS_IMG0, IMG_STRIDE, 32 * ks, 16 * et, lane);
            O[et] = __builtin_amdgcn_mfma_f32_16x16x32_bf16(vf, pf, O[et], 0, 0, 0); }
    }
#pragma unroll
    for (int dir = 0; dir < 2; ++dir) {
        const float al = dir ? alB : alF;
#pragma unroll
        for (int et = 0; et < 8; ++et) { f32x4 x = {0.f, 0.f, 0.f, 0.f};
#pragma unroll
            for (int ks = 0; ks < 4; ++ks) { const bf16x8 cf = *(const LAS bf16x8*)(lds + LDS_CT0 + dir * CT_BYTES + (16 * et + li) * CT_STRIDE + (32 * ks + 8 * g) * 2);
                x = __builtin_amdgcn_mfma_f32_16x16x32_bf16(cf, qf[ks], x, 0, 0, 0); }
            O[et] += x * al; }
    }
    asm volatile("" ::: "memory");
    const size_t row = (size_t)(b * T + oc * 128 + tq);
    const float* gain = P.in[RET ? I_RHN : I_MHN] + (size_t)l * 512 + h * 128 + 4 * g;
    float gt[8][4]; float ss = 0.f;
#pragma unroll
    for (int et = 0; et < 8; ++et) { const v2u w = gwv[et];
        gt[et][0] = lo2f(w.x); gt[et][1] = hi2f(w.x); gt[et][2] = lo2f(w.y); gt[et][3] = hi2f(w.y);
#pragma unroll
        for (int j = 0; j < 4; ++j) { if (!RET) O[et][j] *= sigmoid_f(gt[et][j]); ss += O[et][j] * O[et][j]; } }
    ss += __shfl_xor(ss, 16); ss += __shfl_xor(ss, 32);
    const float rs = rsqrtf(ss * (1.0f / 128.0f) + EPS);
    bf16* op = (bf16*)(P.ws + WS_XN) + row * D + (RET ? 1536 : 0) + h * 128 + 4 * g;
#pragma unroll
    for (int et = 0; et < 8; ++et) { const f32x4 gn = *(const f32x4*)(gain + 16 * et); f32x4 y = O[et] * rs * gn;
        if (RET) { y[0] *= silu_f(gt[et][0]); y[1] *= silu_f(gt[et][1]); y[2] *= silu_f(gt[et][2]); y[3] *= silu_f(gt[et][3]); }
        *(v2u*)(op + 16 * et) = (v2u){pk2(y[0], y[1]), pk2(y[2], y[3])}; }
    __syncthreads();
}

constexpr int NA_TSTRIDE = 288, NA_TBYTES = 64 * NA_TSTRIDE;
__device__ __forceinline__ void na_block_unit(const Params& P, int l, int u, LAS unsigned char* lds, int wv) {
    const int tid = tid_fresh(wv), lane = tid & 63, wave = tid >> 6, g = lane >> 4, li = lane & 15;
    const int rp = u & 15, head = (u >> 4) & 7, b = u >> 7;
    const int n = wave & 3, r = 2 * rp + (wave >> 2);
    const bf16* proj = (const bf16*)(P.ws + WS_PROJ);
    const int r0a = min(max(2 * rp - 4, 0), 24), r0b = min(max(2 * rp - 3, 0), 24), nrows = r0b + 8 - r0a;
    const int r0 = (wave >> 2) ? r0b : r0a, shift = r0 - r0a;
    const int kc0 = (n == 0) ? 0 : (n == 1) ? 8 : (n == 2) ? 24 : 32;
    const int qc = 16 * n + li;
    const size_t qrow = (size_t)(b * T + r * 64 + qc);
    bf16x8 qf[4];
#pragma unroll
    for (int ks = 0; ks < 4; ++ks) qf[ks] = *(const bf16x8*)(proj + qrow * NPJ + PQ_NQ + head * 128 + 32 * ks + 8 * g);
    LAS float* rpb = (LAS float*)(lds + 2 * NA_TBYTES);
    if (tid < 465) rpb[tid] = P.in[I_RPB][((size_t)l * 8 + head) * 465 + tid];
    const int win0 = min(max(qc - 8, 0), 48);
    int dcv[2][4]; bool okv[2][4];
#pragma unroll
    for (int hf = 0; hf < 2; ++hf)
#pragma unroll
        for (int j = 0; j < 4; ++j) { const int kc = kc0 + 16 * hf + 4 * g + j; okv[hf][j] = kc >= win0 && kc < win0 + 16; dcv[hf][j] = min(max(kc - qc + 15, 0), 30); }
    const bf16* kst = proj + (size_t)(b * T + r0a * 64 + (tid >> 4)) * NPJ + PQ_NK + head * 128 + 8 * (tid & 15);
    const bf16* vst = kst + (PQ_NV - PQ_NK);
    LAS unsigned char* wdst = lds + (tid >> 4) * NA_TSTRIDE + (tid & 15) * 16;
    f32x4 sT[16]; float mx = NEGF;
    __syncthreads();
#pragma unroll
    for (int i = 0; i < 8; ++i)
#pragma unroll
        for (int hf = 0; hf < 2; ++hf)
#pragma unroll
            for (int j = 0; j < 4; ++j) sT[2 * i + hf][j] = rpb[(r0 + i - r + 7) * 31 + dcv[hf][j]] * (1.0f / QSCALE);
    constexpr int NA_PF = 4;
    v4u sq[NA_PF][2];
#pragma unroll
    for (int j = 0; j < NA_PF; ++j) { sq[j][0] = *(const v4u*)(kst + (size_t)(j * 64) * NPJ); sq[j][1] = *(const v4u*)(kst + (size_t)(j * 64 + 32) * NPJ); }
#define NA_SROW(I, BUF) do { \
        _Pragma("unroll") for (int hf = 0; hf < 2; ++hf) { f32x4 a_ = sT[2 * (I) + hf]; \
            _Pragma("unroll") for (int ks = 0; ks < 4; ++ks) { const bf16x8 kf_ = *(const LAS bf16x8*)(lds + (BUF) * NA_TBYTES + (kc0 + 16 * hf + li) * NA_TSTRIDE + (32 * ks + 8 * g) * 2); \
                a_ = __builtin_amdgcn_mfma_f32_16x16x32_bf16(kf_, qf[ks], a_, 0, 0, 0); } \
            _Pragma("unroll") for (int j = 0; j < 4; ++j) { const float s_ = okv[hf][j] ? a_[j] * QSCALE : NEGF; a_[j] = s_; mx = fmaxf(mx, s_); } \
            sT[2 * (I) + hf] = a_; } } while (0)
#pragma unroll
    for (int j = 0; j < 9; ++j) {
        if (j < nrows) {
            *(LAS v4u*)(wdst + (j & 1) * NA_TBYTES) = sq[j % NA_PF][0]; *(LAS v4u*)(wdst + (j & 1) * NA_TBYTES + 32 * NA_TSTRIDE) = sq[j % NA_PF][1];
            if (j + NA_PF < nrows) { sq[j % NA_PF][0] = *(const v4u*)(kst + (size_t)((j + NA_PF) * 64) * NPJ); sq[j % NA_PF][1] = *(const v4u*)(kst + (size_t)((j + NA_PF) * 64 + 32) * NPJ); }
            asm volatile("s_waitcnt lgkmcnt(0)" ::: "memory"); __builtin_amdgcn_s_barrier(); asm volatile("" ::: "memory");
            if (shift == 0) { if (j < 8) NA_SROW(j, j & 1); }
            else { if (j >= 1) NA_SROW(j - 1, j & 1); }
        }
    }
#undef NA_SROW
#pragma unroll
    for (int j = 0; j < NA_PF; ++j) { sq[j][0] = *(const v4u*)(vst + (size_t)(j * 64) * NPJ); sq[j][1] = *(const v4u*)(vst + (size_t)(j * 64 + 32) * NPJ); }
    mx = fmaxf(mx, __shfl_xor(mx, 16)); mx = fmaxf(mx, __shfl_xor(mx, 32));
    float sum = 0.f;
#pragma unroll
    for (int kt = 0; kt < 16; ++kt)
#pragma unroll
        for (int j = 0; j < 4; ++j) { const float p = exp_f(sT[kt][j] - mx); sT[kt][j] = p; sum += p; }
    sum += __shfl_xor(sum, 16); sum += __shfl_xor(sum, 32);
    f32x4 O[8];
#pragma unroll
    for (int et = 0; et < 8; ++et) O[et] = (f32x4){0.f, 0.f, 0.f, 0.f};
    __syncthreads();
#define NA_VROW(I, BUF) do { const v4u pw_ = {pk2(sT[2 * (I)][0], sT[2 * (I)][1]), pk2(sT[2 * (I)][2], sT[2 * (I)][3]), pk2(sT[2 * (I) + 1][0], sT[2 * (I) + 1][1]), pk2(sT[2 * (I) + 1][2], sT[2 * (I) + 1][3])}; \
        const bf16x8 pf_ = __builtin_bit_cast(bf16x8, pw_); \
        _Pragma("unroll") for (int et = 0; et < 8; ++et) { const bf16x8 vf_ = tr_frag16p(lds + (BUF) * NA_TBYTES, NA_TSTRIDE, kc0, 16 * et, lane); \
            O[et] = __builtin_amdgcn_mfma_f32_16x16x32_bf16(vf_, pf_, O[et], 0, 0, 0); } } while (0)
#pragma unroll
    for (int j = 0; j < 9; ++j) {
        if (j < nrows) {
            *(LAS v4u*)(wdst + (j & 1) * NA_TBYTES) = sq[j % NA_PF][0]; *(LAS v4u*)(wdst + (j & 1) * NA_TBYTES + 32 * NA_TSTRIDE) = sq[j % NA_PF][1];
            if (j + NA_PF < nrows) { sq[j % NA_PF][0] = *(const v4u*)(vst + (size_t)((j + NA_PF) * 64) * NPJ); sq[j % NA_PF][1] = *(const v4u*)(vst + (size_t)((j + NA_PF) * 64 + 32) * NPJ); }
            asm volatile("s_waitcnt lgkmcnt(0)" ::: "memory"); __builtin_amdgcn_s_barrier(); asm volatile("" ::: "memory");
            if (shift == 0) { if (j < 8) NA_VROW(j, j & 1); }
            else { if (j >= 1) NA_VROW(j - 1, j & 1); }
        }
    }
#undef NA_VROW
    const float rl = 1.0f / sum;
    bf16* op = (bf16*)(P.ws + WS_XN) + qrow * D + 512 + head * 128 + 4 * g;
#pragma unroll
    for (int et = 0; et < 8; ++et) { const f32x4 y = O[et] * rl; *(v2u*)(op + 16 * et) = (v2u){pk2(y[0], y[1]), pk2(y[2], y[3])}; }
    __syncthreads();
}

__device__ __forceinline__ void gate_unit(const Params& P, int l, int item, LAS unsigned char* lds, const unsigned* rowsq, int wv) {
    const int tid = tid_fresh(wv), lane = tid & 63, wave = tid >> 6, g = lane >> 4, li = lane & 15, rt = wave & 3, kh = wave >> 2;
    const bf16* A = (const bf16*)(P.ws + WS_XN) + (size_t)(item * 64 + rt * 16 + li) * D + kh * 1024 + 8 * g;
    const bf16* B = (const bf16*)(P.ws + WS_WIN) + (size_t)(NPJ + li) * D + kh * 1024 + 8 * g;
    f32x4 acc = {0.f, 0.f, 0.f, 0.f};
#pragma unroll 1
    for (int k0 = 0; k0 < 32; k0 += 8) {
        bf16x8 a[8], b[8];
#pragma unroll
        for (int i = 0; i < 8; ++i) { a[i] = *(const bf16x8*)(A + 32 * (k0 + i)); b[i] = *(const bf16x8*)(B + 32 * (k0 + i)); }
#pragma unroll
        for (int i = 0; i < 8; ++i) acc = __builtin_amdgcn_mfma_f32_16x16x32_bf16(a[i], b[i], acc, 0, 0, 0);
    }
    LAS f32x4* xb = (LAS f32x4*)lds + rt * 64 + lane;
    if (kh == 1) *xb = acc;
    __syncthreads();
    if (kh == 0) { const f32x4 o = *xb; float* gp = (float*)(P.ws + WS_GATES) + (size_t)(item * 64 + rt * 16 + 4 * g) * 16 + li;
#pragma unroll
        for (int j = 0; j < 4; ++j) { const float rs = rsqrtf((float)rowsq[item * 64 + rt * 16 + 4 * g + j] * (1.0f / (2048.0f * 4096.0f)) + 1e-6f); gp[j * 16] = (acc[j] + o[j]) * rs; } }
    __syncthreads();
}
__device__ __forceinline__ void scan_phase(const Params& P, int l, int wv) {
    const int gt = blockIdx.x * 512 + tid_fresh(wv), GT = GRID * 512;
    const bf16* cl = (const bf16*)(P.ws + WS_CLOC); bf16* cs = (bf16*)(P.ws + WS_CST);
    const float* mloc = (const float*)(P.ws + WS_MLOC); const float* gtot = (const float*)(P.ws + WS_GTOT);
#pragma unroll 1
    for (int v = gt; v < 128 * 4096 + 64 * 32; v += GT) {
        const bool isn = v >= 128 * 4096;
        const int chain = isn ? (v - 128 * 4096) >> 5 : v >> 12, e4 = isn ? (v - 128 * 4096) & 31 : v & 4095;
        const int typ = chain >> 6, dir = chain & 1, h = (chain >> 1) & 3;
        float dec_r = 0.f; if (typ) dec_r = __builtin_amdgcn_exp2f(128.f * ret_log2g(P, l, dir, h));
        float zz = 0.f; asm volatile("" : "+v"(zz));
        f32x4 st = {zz, zz, zz, zz}; float m = NEGF;
        f32x4 lcv[16];
#pragma unroll
        for (int k = 0; k < 16; ++k) { const int oc = dir ? 15 - k : k; const size_t idx = (size_t)chain * 16 + oc;
            if (isn) lcv[k] = *(const f32x4*)((const float*)(P.ws + WS_NLOC) + idx * 128 + 4 * e4);
            else { const v2u w = *(const v2u*)(cl + idx * 16384 + 4 * e4); lcv[k] = (f32x4){lo2f(w.x), hi2f(w.x), lo2f(w.y), hi2f(w.y)}; } }
#pragma unroll
        for (int k = 0; k < 16; ++k) {
            const int oc = dir ? 15 - k : k; const size_t idx = (size_t)chain * 16 + oc;
            float dec, scl;
            if (typ) { dec = dec_r; scl = 1.f; }
            else { const float gg = gtot[idx], ml = mloc[idx], mn = fmaxf(gg + m, ml); dec = exp_f(gg + m - mn); scl = exp_f(ml - mn);
                if (isn && e4 == 0) ((float*)(P.ws + WS_MST))[idx] = m;
                m = mn; }
            if (isn) { float* ns = (float*)(P.ws + WS_NST) + idx * 128 + 4 * e4; *(f32x4*)ns = st; }
            else { *(v2u*)(cs + idx * 16384 + 4 * e4) = (v2u){pk2(st.x, st.y), pk2(st.z, st.w)}; }
            st = st * dec + lcv[k] * scl;
        }
    }
}
typedef __attribute__((address_space(1))) unsigned gu32;
#define XB_TMO      128
#define XB_XCNT(j)  (256  + 64 * (j))
#define XB_XSUB(j)  (1280 + 64 * (j))
#define XB_XGEN(j)  (2304 + 64 * (j))
#define XB_TOP      3328
#define XB_TOPGEN   3392
#define XCD_BAR_WORDS 3456
#define XB_SPIN_CAP (1u << 18)

__device__ __forceinline__ unsigned xb_ld(unsigned* p)              { return __hip_atomic_load(p, __ATOMIC_RELAXED, __HIP_MEMORY_SCOPE_AGENT); }
__device__ __forceinline__ unsigned xb_add(unsigned* p, unsigned v) { return __hip_atomic_fetch_add(p, v, __ATOMIC_RELAXED, __HIP_MEMORY_SCOPE_AGENT); }
__device__ __forceinline__ unsigned xb_xcc_id() { return (unsigned)__builtin_amdgcn_s_getreg((3 << 11) | 20) & 0xFu; }
#define XB_SPIN(cond, bar) do { unsigned _sp = 0; while (cond) { __builtin_amdgcn_s_sleep(1); \
    if ((++_sp & 255u) == 0u) { if (xb_ld(&(bar)[XB_TMO])) break; if (_sp > XB_SPIN_CAP) { atomicAdd(&(bar)[XB_TMO], 1u); break; } } } } while (0)

struct XcdBarrier {
    unsigned* bar; unsigned x;
    volatile LAS unsigned* st;
};

__device__ __forceinline__ XcdBarrier xcd_barrier_post(unsigned* bar, volatile LAS unsigned* st, int wv) {
    XcdBarrier b; b.bar = bar; b.x = xb_xcc_id(); b.st = st;
    if (wv == 0 && __builtin_amdgcn_mbcnt_hi(~0u, __builtin_amdgcn_mbcnt_lo(~0u, 0u)) == 0u) (void)xb_add(&bar[XB_XCNT(b.x)], 1u);
    return b;
}
__device__ __forceinline__ void xcd_barrier_complete(unsigned* bar, unsigned x, unsigned& nloc, unsigned& nx) {
    const unsigned G = gridDim.x * gridDim.y * gridDim.z;
    unsigned sum, cnt, mine, sp = 0u;
    for (;;) {
        sum = 0u; cnt = 0u; mine = 0u;
#pragma unroll
        for (unsigned j = 0; j < 16; ++j) { const unsigned c = xb_ld(&bar[XB_XCNT(j)]); sum += c; cnt += (c > 0u) ? 1u : 0u; mine = (j == x) ? c : mine; }
        if (sum == G) break;
        __builtin_amdgcn_s_sleep(1);
        if ((++sp & 255u) == 0u) { if (xb_ld(&bar[XB_TMO])) break; if (sp > XB_SPIN_CAP) { atomicAdd(&bar[XB_TMO], 1u); break; } }
    }
    nloc = mine > 0u ? mine : 1u; nx = cnt > 0u ? cnt : 1u;
}

__device__ __forceinline__ void xcd_barrier(const XcdBarrier& b, int wv) {
    asm volatile("s_waitcnt vmcnt(0)" ::: "memory");
    __syncthreads();
    if (wv == 0 && __builtin_amdgcn_mbcnt_hi(~0u, __builtin_amdgcn_mbcnt_lo(~0u, 0u)) == 0u) {
        unsigned* bar = b.bar;
        __builtin_amdgcn_s_waitcnt(0);
        unsigned nloc = b.st[0], nx = b.st[1];
        if (nloc == 0u) { xcd_barrier_complete(bar, b.x, nloc, nx); b.st[0] = nloc; b.st[1] = nx; }
        const unsigned old = xb_add(&bar[XB_XSUB(b.x)], 1u);
        const unsigned gen = old / nloc;
        if (old + 1u == (gen + 1u) * nloc) {
            __builtin_amdgcn_fence(__ATOMIC_RELEASE, "agent");
            asm volatile("s_waitcnt vmcnt(0)" ::: "memory");
            const unsigned og = xb_add(&bar[XB_TOP], 1u);
            const unsigned tg = og / nx;
            if (og + 1u == (tg + 1u) * nx) xb_add(&bar[XB_TOPGEN], 1u);
            else XB_SPIN(xb_ld(&bar[XB_TOPGEN]) == tg, bar);
            __builtin_amdgcn_fence(__ATOMIC_ACQUIRE, "agent");
            xb_add(&bar[XB_XGEN(b.x)], 1u);
            asm volatile("s_waitcnt vmcnt(0)" ::: "memory");
        } else {
            XB_SPIN(xb_ld(&bar[XB_XGEN(b.x)]) == gen, bar);
            __builtin_amdgcn_fence(__ATOMIC_ACQUIRE, "agent");
            asm volatile("s_waitcnt vmcnt(0)" ::: "memory");
        }
    }
    __syncthreads();
}
__device__ __forceinline__ void fill_rstd_table(LAS float* tab, const unsigned* rowsq, int bid, int wv) {
    const int tid = tid_fresh(wv);
#pragma unroll
    for (int i = 0; i < 4; ++i) { const int r = tid + 512 * i; tab[r] = rsqrtf((float)rowsq[(bid & 7) * 2048 + r] * (1.0f / (2048.0f * 4096.0f)) + EPS); }
    __syncthreads();
}
__global__ void __launch_bounds__(512, 2) fwd_kernel(Params P) {
    extern __shared__ __attribute__((aligned(16))) unsigned char lds_raw[];
    LAS unsigned char* lds = (LAS unsigned char*)lds_raw;
    cg::grid_group grid = cg::this_grid();
    const int wv = __builtin_amdgcn_readfirstlane(threadIdx.x >> 6);
    { volatile LAS unsigned* misc = (volatile LAS unsigned*)(lds + MISC_OFF); if (threadIdx.x < 32) misc[threadIdx.x] = 0u;
      if (blockIdx.x == 0) for (int i = threadIdx.x; i < 4096; i += 512) ((unsigned*)P.ws)[i] = 0u; }
    __syncthreads();
    grid.sync();
    const XcdBarrier bar = xcd_barrier_post((unsigned*)P.ws, (volatile LAS unsigned*)(lds + MISC_OFF) + 8, wv);
#define GRID_SYNC() xcd_barrier(bar, wv)
    const int G = GRID, bid = blockIdx.x;
    bf16* xn = (bf16*)(P.ws + WS_XN); bf16* proj = (bf16*)(P.ws + WS_PROJ); bf16* hidden = proj;
    bf16* wgu = (bf16*)(P.ws + WS_WGU); bf16* wdn = (bf16*)(P.ws + WS_WDN); bf16* win = (bf16*)(P.ws + WS_WIN); bf16* wout = (bf16*)(P.ws + WS_WOUT);
    bf16* xnb = (bf16*)(P.ws + WS_CLOC);
    unsigned* rowsq = (unsigned*)(P.ws + WS_ROWSQ);
#pragma unroll 1
    for (int l = 0; l < 2; ++l) {
#if !defined(PH) || (PH & 1)
        convert_weights(P, l, lds, wv);
#endif
        if (l == 0) {
            cast_rows_bf16(P.in[I_X], xn, rowsq, wv);
            unsigned zlo = 0u; asm volatile("" : "+v"(zlo));
#pragma unroll 1
            for (int i = bid * 512 + tid_fresh(wv); i < 8 * M; i += G * 512) __hip_atomic_store(rowsq + M + i, zlo, __ATOMIC_RELAXED, __HIP_MEMORY_SCOPE_AGENT);
        }
        GRID_SYNC();
#pragma unroll 1
        for (int f = 0; f < 2; ++f) {
            if (f == 1) {
#if !defined(PH) || (PH & 128)
                gate_unit(P, l, bid, lds, rowsq + (size_t)(4 * l + 1) * M, wv);
                { pg8::Gemm g{xn, win, M, NPJ, D}; pg8::StaticOrder S; S.init(M, NPJ, G, bid, 4); fill_rstd_table((LAS float*)(lds + 131072), rowsq + (size_t)(4 * l + 1) * M, bid, wv); pg8::EpiProj E{proj, NPJ, (const LAS float*)(lds + 131072)};
                  pg8::gemm_phase<pg8::EpiProj, pg8::StaticOrder, true, true>(lds, g, S, E, wv); }
#endif
                GRID_SYNC();
                prep_phase(P, l, wv);
#pragma unroll 1
                for (int u = (bid & 7) * 32 + (bid >> 3); u < 1024; u += G) {
#if !defined(PH) || (PH & 8)
                    na_block_unit(P, l, u, lds, wv);
#endif
                }
                GRID_SYNC();
#pragma unroll 1
                for (int k4 = 0; k4 < 4; ++k4) { const int u = (k4 >> 1) * 512 + (bid & 7) * 64 + (bid >> 3) + 32 * (k4 & 1);
#if !defined(PH) || (PH & 2)
                    if (u < 512) lin_local_unit<false>(P, l, u >> 6, (u >> 4) & 3, u & 15, lds, wv);
#endif
#if !defined(PH) || (PH & 4)
                    if (u >= 512) lin_local_unit<true>(P, l, (u - 512) >> 6, (u >> 4) & 3, u & 15, lds, wv);
#endif
                }
                GRID_SYNC();
#if !defined(PH) || (PH & 16)
                scan_phase(P, l, wv);
#endif
                GRID_SYNC();
#pragma unroll 1
                for (int k4 = 0; k4 < 4; ++k4) { const int u = (k4 >> 1) * 512 + (bid & 7) * 64 + (bid >> 3) + 32 * (k4 & 1);
#if !defined(PH) || (PH & 32)
                    if (u < 512) lin_out_unit<false>(P, l, u >> 6, (u >> 4) & 3, u & 15, lds, wv);
#endif
#if !defined(PH) || (PH & 64)
                    if (u >= 512) lin_out_unit<true>(P, l, (u - 512) >> 6, (u >> 4) & 3, u & 15, lds, wv);
#endif
                }
                GRID_SYNC();
#if !defined(PH) || (PH & 256)
                { pg8::Gemm g{xn, wout, M, D, D}; pg8::StaticOrder S; S.init(M, D, G, bid, 4); pg8::EpiResid E{P.out, P.out, xnb, rowsq + (size_t)(4 * l + 2) * M, D, 1.0f};
                  pg8::gemm_phase<pg8::EpiResid, pg8::StaticOrder, true, true>(lds, g, S, E, wv); }
#endif
                GRID_SYNC();
            }
#if !defined(PH) || (PH & 512)
            { pg8::Gemm g{f ? xnb : xn, wgu + (size_t)f * NGU * D, M, NGU, D}; pg8::StaticOrder S; S.init(M, NGU, G, bid, 4); fill_rstd_table((LAS float*)(lds + 131072), rowsq + (size_t)(4 * l + 2 * f) * M, bid, wv); pg8::EpiSwiGLU E{hidden, FF, (const LAS float*)(lds + 131072)};
              pg8::gemm_phase<pg8::EpiSwiGLU, pg8::StaticOrder, true, true>(lds, g, S, E, wv); }
#endif
            GRID_SYNC();
#if !defined(PH) || (PH & 1024)
            { pg8::Gemm g{hidden, wdn + (size_t)f * D * FF, M, D, FF}; pg8::StaticOrder S; S.init(M, D, G, bid, 4, 1);
              pg8::EpiResid E{(l == 0 && f == 0) ? P.in[I_X] : P.out, P.out, xn, rowsq + (size_t)(4 * l + (f ? 4 : 1)) * M, D, 0.5f};
              pg8::gemm_phase<pg8::EpiResid, pg8::StaticOrder, true, true>(lds, g, S, E, wv); }
#endif
            GRID_SYNC();
        }
    }
    rms_rows_f32(P.out, P.in[I_FINN], P.out, wv);
}

extern "C" void kernel_launch(void* const* d_in, const int* in_sizes, int n_in, void* d_out, int out_size, void* d_ws, size_t ws_size, hipStream_t stream) {
    static int grid = 0;
    if (grid == 0) {
        if (n_in != 18 || in_sizes[0] != M * D || out_size != M * D || ws_size < WS_END) {
            fprintf(stderr, "kernel_launch: unexpected shapes: n_in %d in0 %d out %d ws %zu (need %zu)\n", n_in, n_in > 0 ? in_sizes[0] : -1, out_size, ws_size, (size_t)WS_END); grid = -1; return; }
        int dev = 0, cus = 0, per_cu = 0;
        (void)hipGetDevice(&dev); (void)hipDeviceGetAttribute(&cus, hipDeviceAttributeMultiprocessorCount, dev);
        (void)hipFuncSetAttribute((const void*)fwd_kernel, hipFuncAttributeMaxDynamicSharedMemorySize, LDS_BYTES);
        (void)hipOccupancyMaxActiveBlocksPerMultiprocessor(&per_cu, (const void*)fwd_kernel, 512, LDS_BYTES);
        if (per_cu < 1) per_cu = 1;
        grid = cus * per_cu;
        if (grid < GRID) { fprintf(stderr, "kernel_launch: this kernel needs %d co-resident workgroups, the device holds %d\n", GRID, grid); grid = -1; return; }
        grid = GRID;
        fprintf(stderr, "kernel_launch: grid %d (cus %d x %d), ws %zu\n", grid, cus, per_cu, ws_size);
    }
    if (grid < 0) return;
    Params p{};
    for (int i = 0; i < 18; ++i) p.in[i] = (const float*)d_in[i];
    p.out = (float*)d_out; p.ws = (unsigned char*)d_ws;
    void* args[] = {&p};
    hipError_t e = hipLaunchCooperativeKernel((const void*)fwd_kernel, dim3(grid), dim3(512), args, LDS_BYTES, stream);
    if (e != hipSuccess) fprintf(stderr, "kernel_launch: cooperative launch failed: %s (grid %d)\n", hipGetErrorString(e), grid);
}
```
